# Optimizing an MI355X kernel written in HIP

```python
import math
import jax, jax.numpy as jnp
from jax import lax
import numpy as np

D_MODEL = 1024
BATCH = 4
SEQ = 8192
DEPTH = 2

MIX_WIDTH = D_MODEL
GDN_WIDTH = MIX_WIDTH // 2
GDN_HEAD_DIM = 128
GDN_HEADS = GDN_WIDTH // GDN_HEAD_DIM
CONV_K = 4
CHUNK = 64
S5_WIDTH = MIX_WIDTH - GDN_WIDTH
S5_GROUP = 16
S5_GROUPS = S5_WIDTH // S5_GROUP
S5_STATE = 64
D_FF = ((8 * D_MODEL // 3 + 127) // 128) * 128
N_MOD = 9
PROJ_WIDTH = 4 * GDN_WIDTH + 2 * GDN_HEADS + S5_WIDTH
EPS = 1e-6

kernel_name = "hybrid_gdn_s5_macaron_block"


def rms_norm(x, w):
    xf = x.astype(jnp.float32)
    y = xf * lax.rsqrt(jnp.mean(xf * xf, axis=-1, keepdims=True) + EPS)
    return (y * w.astype(jnp.float32)).astype(x.dtype)


def l2_normalize(t):
    return t * lax.rsqrt(jnp.sum(t * t, axis=-1, keepdims=True) + EPS)


def modulate(h, shift, scale):
    return h * (1.0 + scale) + shift


def swiglu(h, w_in, w_out):
    gate, up = jnp.split(h @ w_in, 2, axis=-1)
    return (jax.nn.silu(gate) * up) @ w_out


def causal_dwconv(x, w):
    K = w.shape[0]
    L = x.shape[1]
    xp = jnp.pad(x, ((0, 0), (K - 1, 0), (0, 0)))
    return sum(xp[:, j:j + L] * w[j] for j in range(K))


def chunked_gated_delta_rule(q, k, v, beta, g):
    Bsz, H, L, dk = q.shape
    dv = v.shape[-1]
    nc = L // CHUNK
    q = q * (dk ** -0.5)
    rs = lambda t: t.reshape(t.shape[:2] + (nc, CHUNK) + t.shape[3:])
    q, k, v, beta, g = rs(q), rs(k), rs(v), rs(beta), rs(g)
    g = jnp.cumsum(g, axis=-1)
    idx = jnp.arange(CHUNK)
    lower_incl = idx[:, None] >= idx[None, :]
    strict = idx[:, None] > idx[None, :]
    decay = jnp.exp(jnp.where(lower_incl, g[..., :, None] - g[..., None, :], -jnp.inf))
    kb = k * beta[..., None]
    vb = v * beta[..., None]
    lmat = jnp.einsum('bhnik,bhnjk->bhnij', kb, k) * decay * strict
    system = lmat + jnp.eye(CHUNK, dtype=lmat.dtype)
    rhs = jnp.concatenate([vb, kb * jnp.exp(g)[..., None]], axis=-1)
    sol = lax.linalg.triangular_solve(system, rhs, left_side=True, lower=True, unit_diagonal=True)
    w_val, k_cum = sol[..., :dv], sol[..., dv:]
    attn_intra = jnp.einsum('bhnik,bhnjk->bhnij', q, k) * decay
    g_last = g[..., -1]
    k_state = k * jnp.exp(g_last[..., None] - g)[..., None]
    q_state = q * jnp.exp(g)[..., None]

    def step(S, inp):
        qs, ks, kc, wv, attn, gl = inp
        v_new = wv - jnp.einsum('bhck,bhkv->bhcv', kc, S)
        o = jnp.einsum('bhck,bhkv->bhcv', qs, S) + jnp.einsum('bhij,bhjv->bhiv', attn, v_new)
        S = S * jnp.exp(gl)[..., None, None] + jnp.einsum('bhck,bhcv->bhkv', ks, v_new)
        return S, o

    xs = tuple(jnp.moveaxis(t, 2, 0) for t in (q_state, k_state, k_cum, w_val, attn_intra, g_last))
    S0 = jnp.zeros((Bsz, H, dk, dv), dtype=q.dtype)
    _, o = lax.scan(step, S0, xs)
    return jnp.moveaxis(o, 0, 2).reshape(Bsz, H, L, dv)


def _complex_linear_combine(earlier, later):
    ar1, ai1, br1, bi1 = earlier
    ar2, ai2, br2, bi2 = later
    ar = ar2 * ar1 - ai2 * ai1
    ai = ar2 * ai1 + ai2 * ar1
    br = ar2 * br1 - ai2 * bi1 + br2
    bi = ar2 * bi1 + ai2 * br1 + bi2
    return (ar, ai, br, bi)


def s5_mixer(u, a_re, a_im, log_dt, b_re, b_im, c_re, c_im, d, w_glu):
    f32 = jnp.float32
    Bsz, L, _ = u.shape
    u = u.astype(f32).reshape(Bsz, L, S5_GROUPS, S5_GROUP)
    ar = jnp.minimum(a_re.astype(f32), -1e-4)
    ai = a_im.astype(f32)
    dt = jnp.exp(log_dt.astype(f32))[:, None]
    mag = jnp.exp(dt * ar)
    abar_re = mag * jnp.cos(dt * ai)
    abar_im = mag * jnp.sin(dt * ai)
    denom = ar * ar + ai * ai
    zr = abar_re - 1.0
    zi = abar_im
    fr = (zr * ar + zi * ai) / denom
    fi = (zi * ar - zr * ai) / denom
    br = b_re.astype(f32)
    bi = b_im.astype(f32)
    bbar_re = fr[..., None] * br - fi[..., None] * bi
    bbar_im = fr[..., None] * bi + fi[..., None] * br
    bu_re = jnp.einsum('gph,blgh->blgp', bbar_re, u)
    bu_im = jnp.einsum('gph,blgh->blgp', bbar_im, u)
    seq_shape = (1, L, S5_GROUPS, S5_STATE)
    a_seq_re = jnp.broadcast_to(abar_re, seq_shape)
    a_seq_im = jnp.broadcast_to(abar_im, seq_shape)
    _, _, xr, xi = lax.associative_scan(_complex_linear_combine, (a_seq_re, a_seq_im, bu_re, bu_im), axis=1)
    y = (jnp.einsum('ghp,blgp->blgh', c_re.astype(f32), xr)
         - jnp.einsum('ghp,blgp->blgh', c_im.astype(f32), xi)
         + d.astype(f32) * u)
    y = jax.nn.gelu(y.reshape(Bsz, L, S5_WIDTH))
    return y * jax.nn.sigmoid(y @ w_glu.astype(f32))


def hybrid_mixer(h, w_in, conv_w, a_log, dt_bias, gdn_norm_w,
                 s5_a_re, s5_a_im, s5_log_dt, s5_b_re, s5_b_im, s5_c_re, s5_c_im, s5_d, s5_w_glu, w_out):
    f32 = jnp.float32
    Bsz, L, _ = h.shape
    proj = h @ w_in
    qkv, z, beta_in, a_in, u = jnp.split(
        proj, [3 * GDN_WIDTH, 4 * GDN_WIDTH, 4 * GDN_WIDTH + GDN_HEADS, 4 * GDN_WIDTH + 2 * GDN_HEADS], axis=-1)
    qkv = jax.nn.silu(causal_dwconv(qkv, conv_w))
    q, k, v = jnp.split(qkv, 3, axis=-1)
    heads = lambda t: t.reshape(Bsz, L, GDN_HEADS, GDN_HEAD_DIM).transpose(0, 2, 1, 3).astype(f32)
    q = l2_normalize(heads(q))
    k = l2_normalize(heads(k))
    v = heads(v)
    beta = jax.nn.sigmoid(beta_in.astype(f32)).transpose(0, 2, 1)
    g = (-jnp.exp(a_log.astype(f32)) * jax.nn.softplus(a_in.astype(f32) + dt_bias.astype(f32))).transpose(0, 2, 1)
    o = chunked_gated_delta_rule(q, k, v, beta, g).transpose(0, 2, 1, 3)
    o = rms_norm(o, gdn_norm_w) * jax.nn.silu(z.astype(f32).reshape(Bsz, L, GDN_HEADS, GDN_HEAD_DIM))
    y_gdn = o.reshape(Bsz, L, GDN_WIDTH)
    y_s5 = s5_mixer(u, s5_a_re, s5_a_im, s5_log_dt, s5_b_re, s5_b_im, s5_c_re, s5_c_im, s5_d, s5_w_glu)
    y = jnp.concatenate([y_gdn.astype(h.dtype), y_s5.astype(h.dtype)], axis=-1)
    return y @ w_out


def setup_inputs(seed: int = 0) -> dict:
    key = jax.random.key(seed)
    ks = jax.random.split(key, 32)
    nrm = lambda k, shape, s: jax.random.normal(k, shape, jnp.float32) * s
    gain = lambda k, shape: 1.0 + 0.05 * jax.random.normal(k, shape, jnp.float32)
    L_ = DEPTH
    dt_gdn = jnp.exp(jax.random.uniform(ks[14], (L_, GDN_HEADS), jnp.float32, math.log(1e-3), math.log(1e-1)))
    return {
        "x": nrm(ks[0], (BATCH, SEQ, D_MODEL), 1.0),
        "c": nrm(ks[1], (BATCH, D_MODEL), 1.0),
        "w_mod": nrm(ks[2], (L_, D_MODEL, N_MOD * D_MODEL), 0.5 * D_MODEL ** -0.5),
        "b_mod": nrm(ks[3], (L_, N_MOD * D_MODEL), 0.01),
        "ff1_norm_pre": gain(ks[4], (L_, D_MODEL)),
        "ff1_norm_post": gain(ks[5], (L_, D_MODEL)),
        "ff1_w_in": nrm(ks[6], (L_, D_MODEL, 2 * D_FF), D_MODEL ** -0.5),
        "ff1_w_out": nrm(ks[7], (L_, D_FF, D_MODEL), D_FF ** -0.5),
        "mix_norm_pre": gain(ks[8], (L_, D_MODEL)),
        "mix_norm_post": gain(ks[9], (L_, D_MODEL)),
        "mix_w_in": nrm(ks[10], (L_, D_MODEL, PROJ_WIDTH), D_MODEL ** -0.5),
        "conv_w": nrm(ks[11], (L_, CONV_K, 3 * GDN_WIDTH), CONV_K ** -0.5),
        "a_log": jnp.log(jax.random.uniform(ks[12], (L_, GDN_HEADS), jnp.float32, 1.0, 16.0)),
        "dt_bias": dt_gdn + jnp.log(-jnp.expm1(-dt_gdn)),
        "gdn_norm_w": gain(ks[13], (L_, GDN_HEAD_DIM)),
        "s5_a_re": -0.5 + 0.01 * jax.random.normal(ks[15], (L_, S5_GROUPS, S5_STATE), jnp.float32),
        "s5_a_im": jnp.broadcast_to(math.pi * jnp.arange(S5_STATE, dtype=jnp.float32), (L_, S5_GROUPS, S5_STATE)),
        "s5_log_dt": jax.random.uniform(ks[16], (L_, S5_GROUPS), jnp.float32, math.log(1e-3), math.log(1e-1)),
        "s5_b_re": nrm(ks[17], (L_, S5_GROUPS, S5_STATE, S5_GROUP), (2 * S5_GROUP) ** -0.5),
        "s5_b_im": nrm(ks[18], (L_, S5_GROUPS, S5_STATE, S5_GROUP), (2 * S5_GROUP) ** -0.5),
        "s5_c_re": nrm(ks[19], (L_, S5_GROUPS, S5_GROUP, S5_STATE), (2 * S5_STATE) ** -0.5),
        "s5_c_im": nrm(ks[20], (L_, S5_GROUPS, S5_GROUP, S5_STATE), (2 * S5_STATE) ** -0.5),
        "s5_d": nrm(ks[21], (L_, S5_GROUPS, S5_GROUP), 1.0),
        "s5_w_glu": nrm(ks[22], (L_, S5_WIDTH, S5_WIDTH), S5_WIDTH ** -0.5),
        "mix_w_out": nrm(ks[23], (L_, MIX_WIDTH, D_MODEL), MIX_WIDTH ** -0.5),
        "ff2_norm_pre": gain(ks[24], (L_, D_MODEL)),
        "ff2_norm_post": gain(ks[25], (L_, D_MODEL)),
        "ff2_w_in": nrm(ks[26], (L_, D_MODEL, 2 * D_FF), D_MODEL ** -0.5),
        "ff2_w_out": nrm(ks[27], (L_, D_FF, D_MODEL), D_FF ** -0.5),
    }


def reference(x, c, w_mod, b_mod, ff1_norm_pre, ff1_norm_post, ff1_w_in, ff1_w_out,
              mix_norm_pre, mix_norm_post, mix_w_in, conv_w, a_log, dt_bias, gdn_norm_w,
              s5_a_re, s5_a_im, s5_log_dt, s5_b_re, s5_b_im, s5_c_re, s5_c_im, s5_d, s5_w_glu, mix_w_out,
              ff2_norm_pre, ff2_norm_post, ff2_w_in, ff2_w_out):
    c_act = jax.nn.silu(c)
    for l in range(DEPTH):
        mod = (c_act @ w_mod[l] + b_mod[l])[:, None, :]
        sh1, sc1, gt1, sh2, sc2, gt2, sh3, sc3, gt3 = jnp.split(mod, N_MOD, axis=-1)
        h = modulate(rms_norm(x, ff1_norm_pre[l]), sh1, sc1)
        x = x + 0.5 * gt1 * rms_norm(swiglu(h, ff1_w_in[l], ff1_w_out[l]), ff1_norm_post[l])
        h = modulate(rms_norm(x, mix_norm_pre[l]), sh2, sc2)
        y = hybrid_mixer(h, mix_w_in[l], conv_w[l], a_log[l], dt_bias[l], gdn_norm_w[l],
                         s5_a_re[l], s5_a_im[l], s5_log_dt[l], s5_b_re[l], s5_b_im[l],
                         s5_c_re[l], s5_c_im[l], s5_d[l], s5_w_glu[l], mix_w_out[l])
        x = x + gt2 * rms_norm(y, mix_norm_post[l])
        h = modulate(rms_norm(x, ff2_norm_pre[l]), sh3, sc3)
        x = x + 0.5 * gt3 * rms_norm(swiglu(h, ff2_w_in[l], ff2_w_out[l]), ff2_norm_post[l])
    return x
```

```cpp
#include <hip/hip_runtime.h>
#include <hip/hip_cooperative_groups.h>
#include <cstdio>
#include <cstdint>
namespace cg = cooperative_groups;

#define LAS __attribute__((address_space(3)))
typedef unsigned short bf16_t;
typedef short bf16x8 __attribute__((ext_vector_type(8)));
typedef float f32x4 __attribute__((ext_vector_type(4)));
typedef float f32x2 __attribute__((ext_vector_type(2)));
typedef unsigned u32x4 __attribute__((ext_vector_type(4)));
typedef unsigned u32x2 __attribute__((ext_vector_type(2)));
typedef LAS unsigned char* lp_t;

constexpr int DM = 1024, NB = 4, SEQ = 8192, M = NB * SEQ, DEPTH = 2;
constexpr int DFF = 2816, NH = 4, HD = 128, CH = 64, NCH = SEQ / CH;
constexpr int NUNIT = NB * NH * NCH;
constexpr int S5G = 32, S5P = 64, S5H = 16, LSEG = 256, NSEG = SEQ / LSEG;
constexpr int NMOD = 9 * DM;
constexpr int PROJ_W = 2568, MIXN = 2816;
constexpr float EPS = 1e-6f;

namespace pg8 {
constexpr int BM = 256, BK = 64, HALF = 128, HTB = HALF * BK * 2, STAGE_BYTES = 8 * HTB, NXCD = 8, WGM = 8;
__device__ __forceinline__ int lds_byte(int r, int c) { const int st = (r >> 4) * 2 + (c >> 5), rr = r & 15, cc = c & 31, ob = rr * 64 + cc * 2; return st * 1024 + (ob ^ (((ob >> 9) & 1) << 5)); }
__device__ __forceinline__ void stage_rc(int b, int& R, int& C) { const int st = b / 1024, sb = b % 1024, swz = sb ^ (((sb >> 9) & 1) << 5); R = (st >> 1) * 16 + swz / 64; C = (st & 1) * 32 + (swz % 64) / 2; }
__device__ __forceinline__ int perm32(int rho) { const int n = rho >> 4, i = rho & 15; return 8 * (i >> 2) + 4 * n + (i & 3); }
struct Unit { int pm, pn; };
struct Gemm { const bf16_t* A; const bf16_t* Bt; int M, N, K, lda, ldb; };
struct StaticOrder {
    int nM, nN, nwg, G, c;
    __device__ void init(int M_, int N_, int G_, int c_) { nM = M_ / BM; nN = N_ / BM; nwg = nM * nN; G = G_; c = c_; }
    __device__ bool next(int i, Unit& u) const {
        const long L = (long)i * G + c; if (L >= nwg) return false;
        int wgid = (int)L; { const int q = nwg / NXCD, r = nwg % NXCD, xcd = wgid % NXCD, off = wgid / NXCD; wgid = (xcd < r ? xcd * (q + 1) : r * (q + 1) + (xcd - r) * q) + off; }
        const int nig = WGM * nN, gid = wgid / nig, fm = gid * WGM, gsz = (nM - fm) < WGM ? (nM - fm) : WGM;
        u.pm = fm + ((wgid % nig) % gsz); u.pn = (wgid % nig) / gsz; return true;
    }
};
typedef __bf16 bf16x2_t __attribute__((ext_vector_type(2)));
__device__ __forceinline__ unsigned cvt_pk_bf16(float lo, float hi) { f32x2 v = {lo, hi}; bf16x2_t b = __builtin_convertvector(v, bf16x2_t); return __builtin_bit_cast(unsigned, b); }

template <class Epi, bool ALIGN_EPI>
__device__ __forceinline__ void gemm_phase(lp_t lds, const Gemm g, const StaticOrder& S, const Epi& E) {
    int tid_ = threadIdx.x; asm volatile("" : "+v"(tid_));
    const int tid = tid_, wid = __builtin_amdgcn_readfirstlane(tid >> 6), lane = tid & 63, wr = wid >> 2, wc = wid & 3, fr = lane & 15, fq = lane >> 4;
    const int K = g.K, nt = K / BK;
    unsigned voffA[2], voffB[2];
#pragma unroll
    for (int i = 0; i < 2; ++i) { int R, C; stage_rc(tid * 16 + i * 8192, R, C); const int Rb = Epi::PERM ? ((R & ~31) + perm32(R & 31)) : R;
        voffA[i] = (unsigned)(R * g.lda + C) * 2u; voffB[i] = (unsigned)(Rb * g.ldb + C) * 2u; }
    const size_t kstep = (size_t)(BK * 2);
    const size_t hsA = (size_t)HALF * g.lda * 2, hsB = (size_t)HALF * g.ldb * 2, tsA = 2 * hsA, tsB = 2 * hsB;
    const unsigned ldsw = (unsigned)wid * 1024u;
    const int aoff = lds_byte(wr * 64 + fr, fq * 8), boff = lds_byte(wc * 32 + fr, fq * 8);
#define PG8_SA(b, h) (((b) * 2 + (h)) * HTB)
#define PG8_SB(b, h) ((4 + (b) * 2 + (h)) * HTB)
#define PG8_STAGE(bufoff, gbase, voff) do { _Pragma("unroll") for (int _i = 0; _i < 2; ++_i) \
        __builtin_amdgcn_global_load_lds((const unsigned*)((const char*)(gbase) + (voff)[_i]), (LAS unsigned*)(lds + (bufoff) + ldsw + _i * 8192), 16, 0, 0); } while (0)
#define PG8_LDA(dst, b, h) do { _Pragma("unroll") for (int m = 0; m < 4; ++m) _Pragma("unroll") for (int k = 0; k < 2; ++k) dst[m][k] = *(const LAS bf16x8*)(lds + PG8_SA(b, h) + aoff + m * 2048 + k * 1024); } while (0)
#define PG8_LDB(dst, b, h) do { _Pragma("unroll") for (int n = 0; n < 2; ++n) _Pragma("unroll") for (int k = 0; k < 2; ++k) dst[n][k] = *(const LAS bf16x8*)(lds + PG8_SB(b, h) + boff + n * 2048 + k * 1024); } while (0)
#define PG8_MMA(ai, bj, At, Bt) do { __builtin_amdgcn_s_setprio(1); _Pragma("unroll") for (int m = 0; m < 4; ++m) _Pragma("unroll") for (int n = 0; n < 2; ++n) _Pragma("unroll") for (int k = 0; k < 2; ++k) \
        acc[ai][bj][m][n] = __builtin_amdgcn_mfma_f32_16x16x32_bf16(Bt[n][k], At[m][k], acc[ai][bj][m][n], 0, 0, 0); __builtin_amdgcn_s_setprio(0); } while (0)
#define PG8_WAIT_V(n) asm volatile("s_waitcnt vmcnt(" #n ")" ::: "memory")
#define PG8_WAIT_L(n) asm volatile("s_waitcnt lgkmcnt(" #n ")" ::: "memory")
#define PG8_BAR __builtin_amdgcn_s_barrier()
#define PG8_SCHED __builtin_amdgcn_sched_barrier(0)
    Unit cur, nxt; int ui = 0;
    if (!S.next(0, cur)) return;
    f32x4 acc[2][2][4][2];
#pragma unroll
    for (int a = 0; a < 2; ++a)
#pragma unroll
        for (int b = 0; b < 2; ++b)
#pragma unroll
            for (int m = 0; m < 4; ++m)
#pragma unroll
                for (int n = 0; n < 2; ++n) acc[a][b][m][n] = (f32x4){0.f, 0.f, 0.f, 0.f};
    bf16x8 At[4][2], B0[2][2], B1[2][2];
    const char* cA = (const char*)g.A + (size_t)cur.pm * tsA; const char* cB = (const char*)g.Bt + (size_t)cur.pn * tsB;
    PG8_STAGE(PG8_SB(0, 0), cB, voffB); PG8_STAGE(PG8_SB(0, 1), cB + hsB, voffB); PG8_STAGE(PG8_SA(0, 0), cA, voffA); PG8_STAGE(PG8_SA(0, 1), cA + hsA, voffA);
    if (wr == 1) PG8_BAR;
    PG8_WAIT_V(2); PG8_BAR;
    PG8_STAGE(PG8_SB(1, 0), cB + kstep, voffB); PG8_STAGE(PG8_SA(1, 0), cA + kstep, voffA); PG8_STAGE(PG8_SB(1, 1), cB + hsB + kstep, voffB);
    PG8_WAIT_V(6); PG8_BAR;
    for (;;) {
        const bool has_next = S.next(ui + 1, nxt);
        const char* nA = has_next ? (const char*)g.A + (size_t)nxt.pm * tsA : cA; const char* nB = has_next ? (const char*)g.Bt + (size_t)nxt.pn * tsB : cB;
        for (int t = 0; t < nt; t += 2) {
            const bool last = (t == nt - 2);
            const char* a1 = cA + (size_t)(t + 1) * kstep;
            const char* a2 = last ? nA : cA + (size_t)(t + 2) * kstep; const char* b2 = last ? nB : cB + (size_t)(t + 2) * kstep;
            const char* a3 = a2 + kstep; const char* b3 = b2 + kstep;
            PG8_LDB(B0, 0, 0); PG8_LDB(B1, 0, 1); PG8_SCHED; PG8_LDA(At, 0, 0); PG8_STAGE(PG8_SA(1, 1), a1 + hsA, voffA);
            PG8_WAIT_V(8); PG8_WAIT_L(0); PG8_BAR; PG8_MMA(0, 0, At, B0); PG8_MMA(0, 1, At, B1); PG8_BAR; PG8_SCHED;
            PG8_LDA(At, 0, 1); PG8_STAGE(PG8_SB(0, 0), b2, voffB); PG8_STAGE(PG8_SB(0, 1), b2 + hsB, voffB); PG8_STAGE(PG8_SA(0, 0), a2, voffA);
            PG8_WAIT_V(8); PG8_WAIT_L(0); PG8_BAR; PG8_MMA(1, 0, At, B0); PG8_MMA(1, 1, At, B1); PG8_BAR; PG8_SCHED;
            PG8_LDB(B0, 1, 0); PG8_LDB(B1, 1, 1); PG8_SCHED; PG8_LDA(At, 1, 0); PG8_STAGE(PG8_SA(0, 1), a2 + hsA, voffA);
            PG8_WAIT_V(8); PG8_WAIT_L(0); PG8_BAR; PG8_MMA(0, 0, At, B0); PG8_MMA(0, 1, At, B1); PG8_BAR; PG8_SCHED;
            PG8_LDA(At, 1, 1); PG8_STAGE(PG8_SB(1, 0), b3, voffB); PG8_STAGE(PG8_SB(1, 1), b3 + hsB, voffB); PG8_STAGE(PG8_SA(1, 0), a3, voffA);
            PG8_WAIT_V(8); PG8_WAIT_L(0); PG8_BAR; PG8_MMA(1, 0, At, B0); PG8_MMA(1, 1, At, B1); PG8_BAR; PG8_SCHED;
        }
        if constexpr (ALIGN_EPI) { if (wr == 0) PG8_BAR; }
        E(acc, cur, wr, wc, fr, fq);
        if (!has_next) break;
#pragma unroll
        for (int a = 0; a < 2; ++a)
#pragma unroll
            for (int b = 0; b < 2; ++b)
#pragma unroll
                for (int m = 0; m < 4; ++m)
#pragma unroll
                    for (int n = 0; n < 2; ++n) acc[a][b][m][n] = (f32x4){0.f, 0.f, 0.f, 0.f};
        cur = nxt; cA = nA; cB = nB; ++ui;
        if constexpr (ALIGN_EPI) { if (wr == 1) PG8_BAR; }
    }
    PG8_WAIT_V(0);
    if constexpr (!ALIGN_EPI) { if (wr == 0) PG8_BAR; }
    PG8_BAR;
#undef PG8_SA
#undef PG8_SB
#undef PG8_STAGE
#undef PG8_LDA
#undef PG8_LDB
#undef PG8_MMA
#undef PG8_WAIT_V
#undef PG8_WAIT_L
#undef PG8_BAR
#undef PG8_SCHED
}
}
using pg8::cvt_pk_bf16;

__device__ __forceinline__ float bf2f(unsigned v) { return __uint_as_float(v << 16); }
__device__ __forceinline__ float bflo(unsigned w) { return __uint_as_float(w << 16); }
__device__ __forceinline__ float bfhi(unsigned w) { return __uint_as_float(w & 0xffff0000u); }
__device__ __forceinline__ unsigned short f2bf(float f) { return (unsigned short)(cvt_pk_bf16(f, 0.f) & 0xffffu); }
__device__ __forceinline__ float sigmoidf_(float x) { return 1.0f / (1.0f + __expf(-x)); }
__device__ __forceinline__ float siluf_(float x) { return x * sigmoidf_(x); }
__device__ __forceinline__ float gelu_tanh(float y) { const float z = 0.7978845608028654f * (y + 0.044715f * y * y * y); const float t = 1.0f - 2.0f / (1.0f + __expf(2.0f * z)); return 0.5f * y * (1.0f + t); }
__device__ __forceinline__ float wave_sum(float v) {
#pragma unroll
    for (int o = 1; o < 64; o <<= 1) v += __shfl_xor(v, o);
    return v;
}
#define LDS_WAIT() asm volatile("s_waitcnt lgkmcnt(0)" ::: "memory")

struct EpiSwiglu {
    static constexpr bool PERM = true;
    bf16_t* O; int ldc;
    __device__ __forceinline__ void operator()(const f32x4 (&acc)[2][2][4][2], const pg8::Unit& u, int wr, int wc, int fr, int fq) const {
        const int row0 = u.pm * 256 + wr * 64 + fr, col0 = u.pn * 128 + wc * 32 + 8 * fq;
#pragma unroll
        for (int ai = 0; ai < 2; ++ai)
#pragma unroll
            for (int m = 0; m < 4; ++m) {
                const f32x4 g0 = acc[ai][0][m][0], g1 = acc[ai][0][m][1], u0 = acc[ai][1][m][0], u1 = acc[ai][1][m][1];
                u32x4 w;
                w.x = cvt_pk_bf16(siluf_(g0[0]) * u0[0], siluf_(g0[1]) * u0[1]); w.y = cvt_pk_bf16(siluf_(g0[2]) * u0[2], siluf_(g0[3]) * u0[3]);
                w.z = cvt_pk_bf16(siluf_(g1[0]) * u1[0], siluf_(g1[1]) * u1[1]); w.w = cvt_pk_bf16(siluf_(g1[2]) * u1[2], siluf_(g1[3]) * u1[3]);
                *(u32x4*)(O + (size_t)(row0 + ai * 128 + m * 16) * ldc + col0) = w;
                asm volatile("" ::: "memory");
            }
    }
};
struct EpiYraw {
    static constexpr bool PERM = true;
    bf16_t* O; float* part;
    __device__ __forceinline__ void operator()(const f32x4 (&acc)[2][2][4][2], const pg8::Unit& u, int wr, int wc, int fr, int fq) const {
        const int row0 = u.pm * 256 + wr * 64 + fr, col0 = u.pn * 256 + wc * 32 + 8 * fq;
#pragma unroll
        for (int ai = 0; ai < 2; ++ai)
#pragma unroll
            for (int m = 0; m < 4; ++m) {
                const int row = row0 + ai * 128 + m * 16; float ss = 0.f;
#pragma unroll
                for (int bj = 0; bj < 2; ++bj) { const f32x4 v0 = acc[ai][bj][m][0], v1 = acc[ai][bj][m][1];
                    ss += (v0[0] * v0[0] + v0[1] * v0[1]) + (v0[2] * v0[2] + v0[3] * v0[3]) + (v1[0] * v1[0] + v1[1] * v1[1]) + (v1[2] * v1[2] + v1[3] * v1[3]);
                    u32x4 w; w.x = cvt_pk_bf16(v0[0], v0[1]); w.y = cvt_pk_bf16(v0[2], v0[3]); w.z = cvt_pk_bf16(v1[0], v1[1]); w.w = cvt_pk_bf16(v1[2], v1[3]);
                    *(u32x4*)(O + (size_t)row * DM + col0 + bj * 128) = w; }
                ss += __shfl_xor(ss, 16); ss += __shfl_xor(ss, 32);
                if (fq == 0) part[(size_t)row * 16 + u.pn * 4 + wc] = ss;
                asm volatile("" ::: "memory");
            }
    }
};
struct EpiInproj {
    static constexpr bool PERM = true;
    bf16_t *QKV, *Z, *U; float *BETA, *G; const float *a_log, *dt_bias;
    __device__ __forceinline__ void operator()(const f32x4 (&acc)[2][2][4][2], const pg8::Unit& u, int wr, int wc, int fr, int fq) const {
        const int row0 = u.pm * 256 + wr * 64 + fr;
        if (u.pn == 10) {
            if (wc == 0 && fq == 0) {
                const f32x4 al = *(const f32x4*)a_log, db = *(const f32x4*)dt_bias;
#pragma unroll
                for (int ai = 0; ai < 2; ++ai)
#pragma unroll
                    for (int m = 0; m < 4; ++m) { const int row = row0 + ai * 128 + m * 16; const f32x4 bi = acc[ai][0][m][0], an = acc[ai][0][m][1]; f32x4 bo, go;
#pragma unroll
                        for (int j = 0; j < 4; ++j) { bo[j] = 1.0f / (1.0f + expf(-bi[j])); const float xx = an[j] + db[j]; const float sp = xx > 20.f ? xx : log1pf(expf(xx)); go[j] = -expf(al[j]) * sp; }
                        *(f32x4*)(BETA + (size_t)row * 4) = bo; *(f32x4*)(G + (size_t)row * 4) = go; asm volatile("" ::: "memory"); }
            }
            return;
        }
        bf16_t* base; int ldc, colt;
        if (u.pn < 6) { base = QKV; ldc = 1536; colt = u.pn * 256; } else if (u.pn < 8) { base = Z; ldc = 512; colt = (u.pn - 6) * 256; } else { base = U; ldc = 512; colt = (u.pn - 8) * 256; }
        const int col0 = colt + wc * 32 + 8 * fq;
#pragma unroll
        for (int ai = 0; ai < 2; ++ai)
#pragma unroll
            for (int m = 0; m < 4; ++m)
#pragma unroll
                for (int bj = 0; bj < 2; ++bj) { const f32x4 v0 = acc[ai][bj][m][0], v1 = acc[ai][bj][m][1];
                    u32x4 w; w.x = cvt_pk_bf16(v0[0], v0[1]); w.y = cvt_pk_bf16(v0[2], v0[3]); w.z = cvt_pk_bf16(v1[0], v1[1]); w.w = cvt_pk_bf16(v1[2], v1[3]);
                    *(u32x4*)(base + (size_t)(row0 + ai * 128 + m * 16) * ldc + col0 + bj * 128) = w; asm volatile("" ::: "memory"); }
    }
};
struct EpiGlu {
    static constexpr bool PERM = true;
    const bf16_t* YS; bf16_t* YCAT;
    __device__ __forceinline__ void operator()(const f32x4 (&acc)[2][2][4][2], const pg8::Unit& u, int wr, int wc, int fr, int fq) const {
        const int row0 = u.pm * 256 + wr * 64 + fr, col0 = u.pn * 256 + wc * 32 + 8 * fq;
#pragma unroll
        for (int ai = 0; ai < 2; ++ai)
#pragma unroll
            for (int m = 0; m < 4; ++m)
#pragma unroll
                for (int bj = 0; bj < 2; ++bj) { const int row = row0 + ai * 128 + m * 16, col = col0 + bj * 128;
                    const u32x4 y = *(const u32x4*)(YS + (size_t)row * 512 + col); const f32x4 v0 = acc[ai][bj][m][0], v1 = acc[ai][bj][m][1];
                    u32x4 w; w.x = cvt_pk_bf16(bflo(y.x) * sigmoidf_(v0[0]), bfhi(y.x) * sigmoidf_(v0[1])); w.y = cvt_pk_bf16(bflo(y.y) * sigmoidf_(v0[2]), bfhi(y.y) * sigmoidf_(v0[3]));
                    w.z = cvt_pk_bf16(bflo(y.z) * sigmoidf_(v1[0]), bfhi(y.z) * sigmoidf_(v1[1])); w.w = cvt_pk_bf16(bflo(y.w) * sigmoidf_(v1[2]), bfhi(y.w) * sigmoidf_(v1[3]));
                    *(u32x4*)(YCAT + (size_t)row * DM + 512 + col) = w; asm volatile("" ::: "memory"); }
    }
};

constexpr size_t MiB = 1u << 20;
constexpr size_t W_FF_IN = (size_t)2 * DFF * DM * 2, W_FF_OUT = (size_t)DM * DFF * 2, W_MIX_IN = (size_t)MIXN * DM * 2, W_GLU = 512 * 512 * 2, W_MIX_OUT = (size_t)DM * DM * 2;
constexpr size_t WO_FF1_IN = 0, WO_FF1_OUT = WO_FF1_IN + W_FF_IN, WO_MIX_IN = WO_FF1_OUT + W_FF_OUT, WO_GLU = WO_MIX_IN + W_MIX_IN, WO_MIX_OUT = WO_GLU + W_GLU,
                 WO_FF2_IN = WO_MIX_OUT + W_MIX_OUT, WO_FF2_OUT = WO_FF2_IN + W_FF_IN, W_LAYER = WO_FF2_OUT + W_FF_OUT;
static_assert(W_LAYER * 2 <= 84 * MiB, "weights");
constexpr size_t WS_W = 0, WS_H = 84 * MiB, WS_BIG = 148 * MiB, WS_YR = 324 * MiB, WS_EX = 388 * MiB, WS_SMALL = 500 * MiB, WS_END = 512 * MiB;
constexpr size_t WS_QKV = WS_BIG, WS_Z = WS_BIG + 96 * MiB, WS_U = WS_BIG + 128 * MiB;
constexpr size_t WS_SC = WS_BIG;
constexpr size_t WS_D = WS_EX, WS_RT = WS_YR;
constexpr size_t WS_QP = WS_H, WS_O0T = WS_H + 32 * MiB;
constexpr size_t WS_YS = WS_EX + 64 * MiB;
constexpr size_t WS_YCAT = WS_EX;
constexpr size_t WS_PART = WS_SMALL, WS_MOD = WS_PART + 2 * MiB, WS_BETA = WS_MOD + 1 * MiB, WS_G = WS_BETA + 1 * MiB, WS_EGL = WS_G + 1 * MiB, WS_S5E = WS_EGL + 1 * MiB;
static_assert(WS_S5E + 2 * MiB <= WS_END, "small");
constexpr int LDS_BYTES = 147456;
constexpr size_t WS_CTL = WS_SMALL + 10 * MiB, CTL_BYTES = 16384;

struct Args { const float* in[29]; float* out; unsigned char* ws; };

__device__ __forceinline__ int src_col(int maptype, int n) {
    if (maptype == 0) return n;
    if (maptype == 1) { const int t = n >> 8, w = n & 255; return (w < 128) ? t * 128 + w : DFF + t * 128 + (w - 128); }
    return n < 2048 ? n : (n < 2560 ? n + 8 : (n < 2568 ? n - 512 : -1));
}
__device__ __forceinline__ void transpose_item(const float* W, int K, int N, bf16_t* WT, LAS float* scr, int kb, int nb, int maptype, int lane) {
    const int k0 = 64 * kb, n0 = 32 * nb; const int sc = src_col(maptype, n0 + (lane & 31));
#pragma unroll 8
    for (int i = 0; i < 32; ++i) { const int kk = 2 * i + (lane >> 5); scr[kk * 33 + (lane & 31)] = sc >= 0 ? W[(size_t)(k0 + kk) * N + sc] : 0.f; }
    LDS_WAIT(); asm volatile("" ::: "memory");
    const int c = lane & 7;
#pragma unroll
    for (int j = 0; j < 4; ++j) { const int n = (lane >> 3) + 8 * j; const LAS float* s = scr + (8 * c) * 33 + n;
        u32x4 o; o.x = cvt_pk_bf16(s[0 * 33], s[1 * 33]); o.y = cvt_pk_bf16(s[2 * 33], s[3 * 33]); o.z = cvt_pk_bf16(s[4 * 33], s[5 * 33]); o.w = cvt_pk_bf16(s[6 * 33], s[7 * 33]);
        *(u32x4*)(WT + (size_t)(n0 + n) * K + k0 + 8 * c) = o; }
    LDS_WAIT(); asm volatile("" ::: "memory");
}

__device__ __forceinline__ void finalize_phase(const float* xsrc, float* xdst, const bf16_t* yraw, const float* part, const float* gate  , float gs, const float* wpost,
                                               const float* wpre, const float* shift, const float* scale, bf16_t* H, int gw, int NGW, int lane) {
    asm volatile("" : "+v"(lane));
    for (int m = gw; m < M; m += NGW) {
        const int b = m / SEQ;
        f32x4 x[4];
#pragma unroll
        for (int j = 0; j < 4; ++j) x[j] = *(const f32x4*)(xsrc + (size_t)m * DM + 4 * lane + 256 * j);
        if (yraw) {
            float ss = 0.f;
#pragma unroll
            for (int q = 0; q < 4; ++q) { const f32x4 p = *(const f32x4*)(part + (size_t)m * 16 + 4 * q); ss += (p[0] + p[1]) + (p[2] + p[3]); }
            const float rstd = rsqrtf(ss * (1.0f / DM) + EPS) * gs;
#pragma unroll
            for (int j = 0; j < 4; ++j) { const int col = 4 * lane + 256 * j; const u32x2 y = *(const u32x2*)(yraw + (size_t)m * DM + col);
                const f32x4 gt = *(const f32x4*)(gate + (size_t)b * NMOD + col), wp = *(const f32x4*)(wpost + col);
                x[j][0] += gt[0] * wp[0] * rstd * bflo(y.x); x[j][1] += gt[1] * wp[1] * rstd * bfhi(y.x); x[j][2] += gt[2] * wp[2] * rstd * bflo(y.y); x[j][3] += gt[3] * wp[3] * rstd * bfhi(y.y);
                *(f32x4*)(xdst + (size_t)m * DM + col) = x[j]; }
        }
        if (H) {
            float s2 = 0.f;
#pragma unroll
            for (int j = 0; j < 4; ++j) s2 += (x[j][0] * x[j][0] + x[j][1] * x[j][1]) + (x[j][2] * x[j][2] + x[j][3] * x[j][3]);
            const float r2 = rsqrtf(wave_sum(s2) * (1.0f / DM) + EPS);
#pragma unroll
            for (int j = 0; j < 4; ++j) { const int col = 4 * lane + 256 * j; const f32x4 wp = *(const f32x4*)(wpre + col), sh = *(const f32x4*)(shift + (size_t)b * NMOD + col), sc = *(const f32x4*)(scale + (size_t)b * NMOD + col);
                u32x2 o; o.x = cvt_pk_bf16(x[j][0] * r2 * wp[0] * (1.f + sc[0]) + sh[0], x[j][1] * r2 * wp[1] * (1.f + sc[1]) + sh[1]);
                o.y = cvt_pk_bf16(x[j][2] * r2 * wp[2] * (1.f + sc[2]) + sh[2], x[j][3] * r2 * wp[3] * (1.f + sc[3]) + sh[3]);
                *(u32x2*)(H + (size_t)m * DM + col) = o; }
        }
    }
}

__device__ __forceinline__ f32x4 mma_nt(lp_t A, int lda_b, lp_t B, int ldb_b, int nkt, int fr, int fq, f32x4 acc) {
    for (int kt = 0; kt < nkt; ++kt) {
        const bf16x8 a = *(const LAS bf16x8*)(A + fr * lda_b + (kt * 32 + fq * 8) * 2);
        const bf16x8 b = *(const LAS bf16x8*)(B + fr * ldb_b + (kt * 32 + fq * 8) * 2);
        acc = __builtin_amdgcn_mfma_f32_16x16x32_bf16(a, b, acc, 0, 0, 0);
    }
    return acc;
}

constexpr int GP_KN = 0, GP_QS = 17408, GP_V = 34816, GP_KST = 51200, GP_ATT = 67584, GP_A = 76800, GP_TT = 93184, GP_GC = 130048, GP_BETA = 130304, GP_BG = 130560, GP_END = 130816;
constexpr int LD136 = 272, LD72 = 144, LDV = 256, LDKS = 128;
__device__ __forceinline__ void gdn_pre_unit(lp_t lds, int u, const bf16_t* QKV, const float* convw, const float* BETA, const float* G,
                                             bf16_t* Dg, bf16_t* RTg, bf16_t* QPg, bf16_t* O0Tg, float* EGL) {
    int tid_ = threadIdx.x; asm volatile("" : "+v"(tid_));
    const int tid = tid_, wid = __builtin_amdgcn_readfirstlane(tid >> 6), lane = tid & 63, fr = lane & 15, fq = lane >> 4;
    const int b = u >> 9, h = (u >> 7) & 3, c = u & 127;
    const size_t row0 = (size_t)b * SEQ + (size_t)c * CH;
    LAS float* sGC = (LAS float*)(lds + GP_GC); LAS float* sBE = (LAS float*)(lds + GP_BETA);
    if (wid == 0) {
        float v = G[(row0 + lane) * 4 + h];
#ifdef DBG_CONST_GB
        v = -0.01f;
#endif
#pragma unroll
        for (int o = 1; o < 64; o <<= 1) { const float t = __shfl_up(v, o); if (lane >= o) v += t; }
        float be = BETA[(row0 + lane) * 4 + h];
#ifdef DBG_CONST_GB
        be = 0.5f;
#endif
        sGC[lane] = v; sBE[lane] = be; *(LAS float*)(lds + GP_BG + lane * 4) = be * expf(v);
    }
    __syncthreads();
    const float gl = sGC[63];
    {
        const int i = tid >> 3, d0 = (tid & 7) * 16; const float gci = sGC[i];
#pragma unroll 1
        for (int part = 0; part < 3; ++part) {
            const int ch0 = part * 512 + h * 128 + d0;
            float a[16];
#pragma unroll
            for (int e = 0; e < 16; ++e) a[e] = 0.f;
#pragma unroll
            for (int j = 0; j < 4; ++j) {
                const int t = c * CH + i - 3 + j;
                if (t >= 0) {
                    const bf16_t* src = QKV + ((size_t)b * SEQ + t) * 1536 + ch0; const float* wj = convw + j * 1536 + ch0;
                    const u32x4 x0 = *(const u32x4*)src, x1 = *(const u32x4*)(src + 8);
                    const f32x4 w0 = *(const f32x4*)wj, w1 = *(const f32x4*)(wj + 4), w2 = *(const f32x4*)(wj + 8), w3 = *(const f32x4*)(wj + 12);
                    a[0] += w0[0] * bflo(x0.x); a[1] += w0[1] * bfhi(x0.x); a[2] += w0[2] * bflo(x0.y); a[3] += w0[3] * bfhi(x0.y);
                    a[4] += w1[0] * bflo(x0.z); a[5] += w1[1] * bfhi(x0.z); a[6] += w1[2] * bflo(x0.w); a[7] += w1[3] * bfhi(x0.w);
                    a[8] += w2[0] * bflo(x1.x); a[9] += w2[1] * bfhi(x1.x); a[10] += w2[2] * bflo(x1.y); a[11] += w2[3] * bfhi(x1.y);
                    a[12] += w3[0] * bflo(x1.z); a[13] += w3[1] * bfhi(x1.z); a[14] += w3[2] * bflo(x1.w); a[15] += w3[3] * bfhi(x1.w);
                }
            }
            float ss = 0.f;
#pragma unroll
            for (int e = 0; e < 16; ++e) { a[e] = a[e] / (1.0f + expf(-a[e])); ss += a[e] * a[e]; }
            ss += __shfl_xor(ss, 1); ss += __shfl_xor(ss, 2); ss += __shfl_xor(ss, 4);
            float sc = 1.f;
            if (part == 0) sc = rsqrtf(ss + EPS) * 0.08838834764831845f; else if (part == 1) sc = rsqrtf(ss + EPS);
            const lp_t dst = lds + (part == 0 ? GP_QS : (part == 1 ? GP_KN : GP_V)) + i * (part == 2 ? LDV : LD136) + d0 * 2;
            u32x4 o0, o1;
            o0.x = cvt_pk_bf16(a[0] * sc, a[1] * sc); o0.y = cvt_pk_bf16(a[2] * sc, a[3] * sc); o0.z = cvt_pk_bf16(a[4] * sc, a[5] * sc); o0.w = cvt_pk_bf16(a[6] * sc, a[7] * sc);
            o1.x = cvt_pk_bf16(a[8] * sc, a[9] * sc); o1.y = cvt_pk_bf16(a[10] * sc, a[11] * sc); o1.z = cvt_pk_bf16(a[12] * sc, a[13] * sc); o1.w = cvt_pk_bf16(a[14] * sc, a[15] * sc);
            *(LAS u32x4*)dst = o0; *(LAS u32x4*)(dst + 16) = o1;
            if (part == 1) { const float ks = sc * expf(gl - gci);
#pragma unroll
                for (int e = 0; e < 16; ++e) *(LAS unsigned short*)(lds + GP_KST + (d0 + e) * LDKS + i * 2) = f2bf(a[e] * ks); }
        }
    }
    __syncthreads();
    {
#pragma unroll 1
        for (int q = 0; q < 4; ++q) {
            const int idx = wid * 4 + q, isq = idx >> 4, mt = (idx >> 2) & 3, nt = idx & 3;
            f32x4 acc = (f32x4){0.f, 0.f, 0.f, 0.f};
            acc = mma_nt(lds + (isq ? GP_QS : GP_KN) + mt * 16 * LD136, LD136, lds + GP_KN + nt * 16 * LD136, LD136, 4, fr, fq, acc);
            const int jc = nt * 16 + fr; const float gcj = sGC[jc];
#pragma unroll
            for (int jj = 0; jj < 4; ++jj) { const int i = mt * 16 + 4 * fq + jj; const float dec = expf(fminf(sGC[i] - gcj, 0.f));
                if (isq) *(LAS unsigned short*)(lds + GP_ATT + i * LD72 + jc * 2) = f2bf(i >= jc ? acc[jj] * dec : 0.f);
                else *(LAS float*)(lds + GP_A + (i * 64 + jc) * 4) = (i > jc) ? sBE[i] * acc[jj] * dec : 0.f; }
        }
    }
    __syncthreads();
    if (wid < 4) {
        const int col = wid * 64 + lane;
        unsigned lbA = (unsigned)(size_t)(lds + GP_A), lbS = (unsigned)(size_t)(lds + (wid < 2 ? GP_BETA : GP_BG));
        asm volatile("" : "+v"(lbA), "+v"(lbS));
        const lp_t pA = (lp_t)lbA, pS = (lp_t)lbS;
        const lp_t pR = (wid < 2) ? (lds + GP_V + col * 2) : (lds + GP_KN + (col - 128) * 2);
        float T[64];
#pragma unroll
        for (int i = 0; i < 64; ++i) {
            float acc = *(const LAS float*)(pS + i * 4) * bf2f(*(const LAS unsigned short*)(pR + i * (wid < 2 ? LDV : LD136)));
#pragma unroll
#ifdef DBG_NOSOLVE
            for (int j4 = 0; j4 < 0; ++j4) { const f32x4 a = *(const LAS f32x4*)(pA + (i * 64 + j4 * 4) * 4);
#else
            for (int j4 = 0; j4 < (i + 3) / 4; ++j4) { const f32x4 a = *(const LAS f32x4*)(pA + (i * 64 + j4 * 4) * 4);
#endif
                acc = __builtin_fmaf(-a[0], T[j4 * 4], acc);
                if (j4 * 4 + 1 < i) acc = __builtin_fmaf(-a[1], T[j4 * 4 + 1], acc);
                if (j4 * 4 + 2 < i) acc = __builtin_fmaf(-a[2], T[j4 * 4 + 2], acc);
                if (j4 * 4 + 3 < i) acc = __builtin_fmaf(-a[3], T[j4 * 4 + 3], acc); }
            T[i] = acc;
            asm volatile("" ::: "memory");
        }
        const lp_t pT = lds + GP_TT + col * LD72;
#pragma unroll
        for (int q = 0; q < 8; ++q) { u32x4 o; o.x = cvt_pk_bf16(T[8 * q], T[8 * q + 1]); o.y = cvt_pk_bf16(T[8 * q + 2], T[8 * q + 3]); o.z = cvt_pk_bf16(T[8 * q + 4], T[8 * q + 5]); o.w = cvt_pk_bf16(T[8 * q + 6], T[8 * q + 7]);
            *(LAS u32x4*)(pT + q * 16) = o; }
    }
    __syncthreads();
    {
        bf16_t* Du = Dg + (size_t)u * 16384; bf16_t* RTu = RTg + (size_t)u * 16384; bf16_t* QPu = QPg + (size_t)u * 8192; bf16_t* O0u = O0Tg + (size_t)u * 8192;
#pragma unroll 1
        for (int q = 0; q < 24; ++q) {
            const int idx = wid * 24 + q;
            f32x4 acc = (f32x4){0.f, 0.f, 0.f, 0.f};
            if (idx < 32) {
                const int dt = idx >> 2, it = idx & 3;
                acc = mma_nt(lds + GP_TT + (128 + dt * 16) * LD72, LD72, lds + GP_ATT + it * 16 * LD72, LD72, 2, fr, fq, acc);
                const int i = it * 16 + fr, d = dt * 16 + 4 * fq; const float eg = expf(sGC[i]);
                const u32x2 qv = *(const LAS u32x2*)(lds + GP_QS + i * LD136 + d * 2);
                u32x2 o; o.x = cvt_pk_bf16(bflo(qv.x) * eg - acc[0], bfhi(qv.x) * eg - acc[1]); o.y = cvt_pk_bf16(bflo(qv.y) * eg - acc[2], bfhi(qv.y) * eg - acc[3]);
                *(u32x2*)(QPu + i * 128 + d) = o;
            } else if (idx < 64) {
                const int it = (idx - 32) >> 3, nt = (idx - 32) & 7;
                acc = mma_nt(lds + GP_ATT + it * 16 * LD72, LD72, lds + GP_TT + nt * 16 * LD72, LD72, 2, fr, fq, acc);
                const int n = nt * 16 + fr, i = it * 16 + 4 * fq;
#ifdef DBG_O0PATTERN
                acc[0] = 0.01f * (float)((n + i) & 31); acc[1] = -acc[0]; acc[2] = 0.5f * acc[0]; acc[3] = 0.25f;
#endif
                u32x2 o; o.x = cvt_pk_bf16(acc[0], acc[1]); o.y = cvt_pk_bf16(acc[2], acc[3]);
                *(u32x2*)(O0u + n * 64 + i) = o;
            } else if (idx < 128) {
                const int kt = (idx - 64) >> 3, mt = (idx - 64) & 7;
                acc = mma_nt(lds + GP_TT + (128 + kt * 16) * LD72, LD72, lds + GP_KST + mt * 16 * LDKS, LDKS, 2, fr, fq, acc);
                const int m = mt * 16 + fr, k = kt * 16 + 4 * fq;
                u32x2 o; o.x = cvt_pk_bf16(acc[0], acc[1]); o.y = cvt_pk_bf16(acc[2], acc[3]);
                *(u32x2*)(Du + m * 128 + k) = o;
            } else {
                const int mt = (idx - 128) >> 3, nt = (idx - 128) & 7;
                acc = mma_nt(lds + GP_KST + mt * 16 * LDKS, LDKS, lds + GP_TT + nt * 16 * LD72, LD72, 2, fr, fq, acc);
                const int n = nt * 16 + fr, m = mt * 16 + 4 * fq;
                u32x2 o; o.x = cvt_pk_bf16(acc[0], acc[1]); o.y = cvt_pk_bf16(acc[2], acc[3]);
                *(u32x2*)(RTu + n * 128 + m) = o;
            }
        }
        if (tid == 0) EGL[u] = expf(gl);
    }
    __syncthreads();
}

struct ScanRegs { bf16x8 d[4][4]; u32x2 r[4]; float egl; };
__device__ __forceinline__ void scan_load(ScanRegs& R, const bf16_t* Dg, const bf16_t* RTg, const float* EGL, int u, int rh, int n0, int fr, int fq) {
    const bf16_t* Du = Dg + (size_t)u * 16384 + (64 * rh + fr) * 128 + 8 * fq; const bf16_t* RTu = RTg + (size_t)u * 16384 + (n0 + fr) * 128 + 64 * rh + 4 * fq;
    asm volatile("" : "+v"(Du), "+v"(RTu));
#pragma unroll
    for (int mt = 0; mt < 4; ++mt) {
#pragma unroll
        for (int kt = 0; kt < 4; ++kt) R.d[mt][kt] = *(const bf16x8*)(Du + (16 * mt) * 128 + 32 * kt);
        R.r[mt] = *(const u32x2*)(RTu + 16 * mt);
    }
    R.egl = EGL[u];
}
__device__ __forceinline__ void scan_step(lp_t lds, int cur, const ScanRegs& R, f32x4 (&acc)[4], bf16_t* SCg, int u, int cs, int rh, int n0, int fr, int fq) {
    const lp_t img = lds + cur * 17408, nimg = lds + (cur ^ 1) * 17408;
    bf16x8 b[4];
#pragma unroll
    for (int kt = 0; kt < 4; ++kt) b[kt] = *(const LAS bf16x8*)(img + (16 * cs + fr) * LD136 + (32 * kt + 8 * fq) * 2);
    bf16_t* SCu = SCg + (size_t)u * 16384 + (size_t)(n0 + fr) * 128;
    if (rh == 0) { *(bf16x8*)(SCu + 8 * fq) = b[0]; *(bf16x8*)(SCu + 32 + 8 * fq) = b[1]; } else { *(bf16x8*)(SCu + 64 + 8 * fq) = b[2]; *(bf16x8*)(SCu + 96 + 8 * fq) = b[3]; }
#pragma unroll
    for (int mt = 0; mt < 4; ++mt) {
        f32x4 t = (f32x4){0.f, 0.f, 0.f, 0.f};
#pragma unroll
        for (int kt = 0; kt < 4; ++kt) t = __builtin_amdgcn_mfma_f32_16x16x32_bf16(R.d[mt][kt], b[kt], t, 0, 0, 0);
        acc[mt][0] = R.egl * acc[mt][0] + bflo(R.r[mt].x) - t[0]; acc[mt][1] = R.egl * acc[mt][1] + bfhi(R.r[mt].x) - t[1];
        acc[mt][2] = R.egl * acc[mt][2] + bflo(R.r[mt].y) - t[2]; acc[mt][3] = R.egl * acc[mt][3] + bfhi(R.r[mt].y) - t[3];
        u32x2 o; o.x = cvt_pk_bf16(acc[mt][0], acc[mt][1]); o.y = cvt_pk_bf16(acc[mt][2], acc[mt][3]);
        *(LAS u32x2*)(nimg + (16 * cs + fr) * LD136 + (64 * rh + 16 * mt + 4 * fq) * 2) = o;
    }
}
__device__ __forceinline__ void gdn_scan(lp_t lds, int bhh, const bf16_t* Dg, const bf16_t* RTg, const float* EGL, bf16_t* SCg) {
    int tid_ = threadIdx.x; asm volatile("" : "+v"(tid_));
    const int tid = tid_, wid = __builtin_amdgcn_readfirstlane(tid >> 6), lane = tid & 63, fr = lane & 15, fq = lane >> 4;
    const int bh = bhh >> 1, half = bhh & 1, cs = wid & 3, rh = wid >> 2, n0 = half * 64 + cs * 16, u0 = bh * NCH;
    for (int i = tid; i < 2 * 17408 / 4; i += 512) ((LAS unsigned*)lds)[i] = 0u;
    f32x4 acc[4];
#pragma unroll
    for (int mt = 0; mt < 4; ++mt) acc[mt] = (f32x4){0.f, 0.f, 0.f, 0.f};
    ScanRegs R0, R1;
    scan_load(R0, Dg, RTg, EGL, u0, rh, n0, fr, fq);
    __syncthreads();
#pragma unroll 1
    for (int c = 0; c < NCH; c += 2) {
        scan_load(R1, Dg, RTg, EGL, u0 + c + 1, rh, n0, fr, fq);
        scan_step(lds, 0, R0, acc, SCg, u0 + c, cs, rh, n0, fr, fq);
        __syncthreads();
        scan_load(R0, Dg, RTg, EGL, u0 + (c + 2 < NCH ? c + 2 : c), rh, n0, fr, fq);
        scan_step(lds, 1, R1, acc, SCg, u0 + c + 1, cs, rh, n0, fr, fq);
        __syncthreads();
    }
}

__device__ __forceinline__ void gdn_out_pair(int pairidx, const bf16_t* QPg, const bf16_t* O0Tg, const bf16_t* SCg, const bf16_t* Z, const float* gnw, bf16_t* YCAT) {
    int tid_ = threadIdx.x; asm volatile("" : "+v"(tid_));
    const int tid = tid_, wid = __builtin_amdgcn_readfirstlane(tid >> 6), lane = tid & 63, fr = lane & 15, fq = lane >> 4;
    const int u = pairidx * 2 + (wid >> 2), mt = wid & 3;
    const int b = u >> 9, h = (u >> 7) & 3, c = u & 127;
    const bf16_t* QPu = QPg + (size_t)u * 8192; const bf16_t* O0u = O0Tg + (size_t)u * 8192; const bf16_t* SCu = SCg + (size_t)u * 16384;
    bf16x8 a[4];
#pragma unroll
    for (int kt = 0; kt < 4; ++kt) a[kt] = *(const bf16x8*)(QPu + (16 * mt + fr) * 128 + 32 * kt + 8 * fq);
    f32x4 acc[8]; float ss[4] = {0.f, 0.f, 0.f, 0.f};
#pragma unroll
    for (int nt = 0; nt < 8; ++nt) {
        const u32x2 o0 = *(const u32x2*)(O0u + (16 * nt + fr) * 64 + 16 * mt + 4 * fq);
        acc[nt] = (f32x4){bflo(o0.x), bfhi(o0.x), bflo(o0.y), bfhi(o0.y)};
#ifndef DBG_NO_STATE
#pragma unroll
        for (int kt = 0; kt < 4; ++kt) { const bf16x8 bb = *(const bf16x8*)(SCu + (16 * nt + fr) * 128 + 32 * kt + 8 * fq); acc[nt] = __builtin_amdgcn_mfma_f32_16x16x32_bf16(a[kt], bb, acc[nt], 0, 0, 0); }
#endif
#pragma unroll
        for (int j = 0; j < 4; ++j) ss[j] += acc[nt][j] * acc[nt][j];
    }
#pragma unroll
    for (int j = 0; j < 4; ++j) { float s = ss[j]; s += __shfl_xor(s, 1); s += __shfl_xor(s, 2); s += __shfl_xor(s, 4); s += __shfl_xor(s, 8); ss[j] = rsqrtf(s * (1.0f / HD) + EPS); }
    const size_t row0 = (size_t)b * SEQ + (size_t)c * CH + 16 * mt + 4 * fq;
#pragma unroll
    for (int nt = 0; nt < 8; ++nt) { const int n = 16 * nt + fr; const float w = gnw[n];
#pragma unroll
        for (int j = 0; j < 4; ++j) { const float z = bf2f(Z[(row0 + j) * 512 + h * 128 + n]); float ov = acc[nt][j] * ss[j] * w * siluf_(z);
#ifdef DBG_GDN_ZERO
            ov = 0.f;
#endif
#ifdef DBG_ZONLY
            ov = siluf_(z) * w;
#endif
#ifdef DBG_O0ONLY
            ov = acc[nt][j];
#endif
#ifdef DBG_SANITIZE
            if (!(fabsf(ov) < 1e30f)) ov = 0.f;
#endif
            YCAT[(row0 + j) * DM + h * 128 + n] = f2bf(ov); } }
}

struct S5Par { float are, aim, bbr[16], bbi[16]; };
__device__ __forceinline__ void s5_params(S5Par& P, int g, int p, const float* a_re, const float* a_im, const float* log_dt, const float* b_re, const float* b_im) {
    const float ar = fminf(a_re[g * 64 + p], -1e-4f), ai = a_im[g * 64 + p], dt = expf(log_dt[g]);
    const float mag = expf(dt * ar); P.are = mag * cosf(dt * ai); P.aim = mag * sinf(dt * ai);
    const float den = ar * ar + ai * ai, zr = P.are - 1.0f, zi = P.aim, f_r = (zr * ar + zi * ai) / den, f_i = (zi * ar - zr * ai) / den;
#pragma unroll
    for (int q = 0; q < 4; ++q) { const f32x4 br = *(const f32x4*)(b_re + (size_t)(g * 64 + p) * 16 + 4 * q), bi = *(const f32x4*)(b_im + (size_t)(g * 64 + p) * 16 + 4 * q);
#pragma unroll
        for (int e = 0; e < 4; ++e) { P.bbr[4 * q + e] = f_r * br[e] - f_i * bi[e]; P.bbi[4 * q + e] = f_r * bi[e] + f_i * br[e]; } }
}
__device__ __forceinline__ void s5_load_u(LAS float* su, const bf16_t* U, size_t row, int g, int lane) {
    const bf16_t* src = U + (row + lane) * 512 + g * 16; const u32x4 x0 = *(const u32x4*)src, x1 = *(const u32x4*)(src + 8);
    LAS f32x4* d = (LAS f32x4*)(su + lane * 16);
    d[0] = (f32x4){bflo(x0.x), bfhi(x0.x), bflo(x0.y), bfhi(x0.y)}; d[1] = (f32x4){bflo(x0.z), bfhi(x0.z), bflo(x0.w), bfhi(x0.w)};
    d[2] = (f32x4){bflo(x1.x), bfhi(x1.x), bflo(x1.y), bfhi(x1.y)}; d[3] = (f32x4){bflo(x1.z), bfhi(x1.z), bflo(x1.w), bfhi(x1.w)};
}
__device__ __forceinline__ void s5_step(const S5Par& P, const LAS float* su, int t, float& xr, float& xi) {
    const LAS f32x4* uu = (const LAS f32x4*)(su + t * 16); float br = 0.f, bi = 0.f;
#pragma unroll
    for (int q = 0; q < 4; ++q) { const f32x4 v = uu[q];
#pragma unroll
        for (int e = 0; e < 4; ++e) { br += P.bbr[4 * q + e] * v[e]; bi += P.bbi[4 * q + e] * v[e]; } }
    const float nr = P.are * xr - P.aim * xi + br, ni = P.are * xi + P.aim * xr + bi; xr = nr; xi = ni;
}
__device__ __forceinline__ void s5_pass_a(lp_t wlds, int v, const bf16_t* U, float* E, const float* a_re, const float* a_im, const float* log_dt, const float* b_re, const float* b_im, int lane) {
    asm volatile("" : "+v"(lane));
    const int seg = v & (NSEG - 1), g = (v >> 5) & 31, b = v >> 10;
    S5Par P; s5_params(P, g, lane, a_re, a_im, log_dt, b_re, b_im);
    LAS float* su = (LAS float*)wlds; float xr = 0.f, xi = 0.f;
    const size_t row0 = (size_t)b * SEQ + (size_t)seg * LSEG;
#pragma unroll 1
    for (int tile = 0; tile < LSEG / 64; ++tile) {
        s5_load_u(su, U, row0 + tile * 64, g, lane);
        LDS_WAIT(); asm volatile("" ::: "memory");
#pragma unroll 4
        for (int t = 0; t < 64; ++t) s5_step(P, su, t, xr, xi);
        LDS_WAIT(); asm volatile("" ::: "memory");
    }
    *(f32x2*)(E + ((size_t)v * 64 + lane) * 2) = (f32x2){xr, xi};
}
__device__ __forceinline__ void s5_pass_b(lp_t wlds, int v, const bf16_t* U, const float* E, const float* a_re, const float* a_im, const float* log_dt, const float* b_re, const float* b_im,
                                          const float* c_re, const float* c_im, const float* dvec, bf16_t* YS, int lane) {
    asm volatile("" : "+v"(lane));
    const int seg = v & (NSEG - 1), g = (v >> 5) & 31, b = v >> 10, fr = lane & 15, fq = lane >> 4;
    S5Par P; s5_params(P, g, lane, a_re, a_im, log_dt, b_re, b_im);
    float pr = P.are, pi = P.aim;
#pragma unroll
    for (int s = 0; s < 8; ++s) { const float nr = pr * pr - pi * pi, ni = 2.0f * pr * pi; pr = nr; pi = ni; }
    float xr = 0.f, xi = 0.f;
    for (int s = 0; s < seg; ++s) { const f32x2 e = *(const f32x2*)(E + ((size_t)(v - seg + s) * 64 + lane) * 2); const float nr = pr * xr - pi * xi + e[0], ni = pr * xi + pi * xr + e[1]; xr = nr; xi = ni; }
    bf16x8 cb[4];
#pragma unroll
    for (int kt = 0; kt < 4; ++kt) { const float* src = (kt < 2 ? c_re : c_im) + (size_t)(g * 16 + fr) * 64 + 32 * (kt & 1) + 8 * fq; const float sg = kt < 2 ? 1.f : -1.f;
        const f32x4 v0 = *(const f32x4*)src, v1 = *(const f32x4*)(src + 4); u32x4 w; w.x = cvt_pk_bf16(sg * v0[0], sg * v0[1]); w.y = cvt_pk_bf16(sg * v0[2], sg * v0[3]); w.z = cvt_pk_bf16(sg * v1[0], sg * v1[1]); w.w = cvt_pk_bf16(sg * v1[2], sg * v1[3]);
        cb[kt] = __builtin_bit_cast(bf16x8, w); }
    const float dco = dvec[g * 16 + fr];
    LAS float* su = (LAS float*)wlds; const lp_t xt = wlds + 4096;
    const size_t row0 = (size_t)b * SEQ + (size_t)seg * LSEG;
#pragma unroll 1
    for (int tile = 0; tile < LSEG / 64; ++tile) {
        s5_load_u(su, U, row0 + tile * 64, g, lane);
        LDS_WAIT(); asm volatile("" ::: "memory");
#pragma unroll 1
        for (int sub = 0; sub < 4; ++sub) {
#pragma unroll 4
            for (int tt = 0; tt < 16; ++tt) { s5_step(P, su, sub * 16 + tt, xr, xi);
                *(LAS unsigned short*)(xt + tt * LD136 + lane * 2) = f2bf(xr); *(LAS unsigned short*)(xt + tt * LD136 + (64 + lane) * 2) = f2bf(xi); }
            LDS_WAIT(); asm volatile("" ::: "memory");
            f32x4 acc = (f32x4){0.f, 0.f, 0.f, 0.f};
#pragma unroll
            for (int kt = 0; kt < 4; ++kt) { const bf16x8 a = *(const LAS bf16x8*)(xt + fr * LD136 + (32 * kt + 8 * fq) * 2); acc = __builtin_amdgcn_mfma_f32_16x16x32_bf16(a, cb[kt], acc, 0, 0, 0); }
#pragma unroll
            for (int j = 0; j < 4; ++j) { const int t = sub * 16 + 4 * fq + j; const float y = acc[j] + dco * su[t * 16 + fr];
                YS[(row0 + tile * 64 + t) * 512 + g * 16 + fr] = f2bf(gelu_tanh(y)); }
            LDS_WAIT(); asm volatile("" ::: "memory");
        }
    }
}


#define XB_TMO      128
#define XB_XCNT(j)  (256  + 64 * (j))
#define XB_XSUB(j)  (1280 + 64 * (j))
#define XB_XGEN(j)  (2304 + 64 * (j))
#define XB_TOP      3328
#define XB_TOPGEN   3392
#define XCD_BAR_WORDS 3456
#define XB_SPIN_CAP (1u << 22)
__device__ __forceinline__ unsigned xb_ld(unsigned* p)              { return __hip_atomic_load(p, __ATOMIC_RELAXED, __HIP_MEMORY_SCOPE_AGENT); }
__device__ __forceinline__ unsigned xb_add(unsigned* p, unsigned v) { return __hip_atomic_fetch_add(p, v, __ATOMIC_RELAXED, __HIP_MEMORY_SCOPE_AGENT); }
__device__ __forceinline__ unsigned xb_xcc_id() { return (unsigned)__builtin_amdgcn_s_getreg((3 << 11) | 20) & 0xFu; }
#define XB_SPIN(cond, bar) do { unsigned _sp = 0; while (cond) { __builtin_amdgcn_s_sleep(1); \
    if ((++_sp & 255u) == 0u) { if (xb_ld(&(bar)[XB_TMO])) break; if (_sp > XB_SPIN_CAP) { atomicAdd(&(bar)[XB_TMO], 1u); break; } } } } while (0)
struct XcdBarrier { unsigned* bar; unsigned x; volatile LAS unsigned* st; };
__device__ __forceinline__ XcdBarrier xcd_barrier_post(unsigned* bar, volatile LAS unsigned* st) {
    XcdBarrier b; b.bar = bar; b.x = xb_xcc_id(); b.st = st;
    if (threadIdx.x == 0) (void)xb_add(&bar[XB_XCNT(b.x)], 1u);
    return b;
}
__device__ __forceinline__ void xcd_barrier_complete(unsigned* bar, unsigned x, unsigned& nloc, unsigned& nx) {
    const unsigned G = gridDim.x * gridDim.y * gridDim.z;
    unsigned sum, cnt, mine, sp = 0u;
    for (;;) {
        sum = 0u; cnt = 0u; mine = 0u;
#pragma unroll
        for (unsigned j = 0; j < 16; ++j) { const unsigned c = xb_ld(&bar[XB_XCNT(j)]); sum += c; cnt += (c > 0u) ? 1u : 0u; mine = (j == x) ? c : mine; }
        if (sum == G) break;
        __builtin_amdgcn_s_sleep(1);
        if ((++sp & 255u) == 0u) { if (xb_ld(&bar[XB_TMO])) break; if (sp > XB_SPIN_CAP) { atomicAdd(&bar[XB_TMO], 1u); break; } }
    }
    nloc = mine > 0u ? mine : 1u; nx = cnt > 0u ? cnt : 1u;
}
__device__ __forceinline__ void xcd_barrier(const XcdBarrier& b) {
    asm volatile("s_waitcnt vmcnt(0) lgkmcnt(0)" ::: "memory");
    __syncthreads();
    if (threadIdx.x == 0) {
        unsigned* bar = b.bar;
        __builtin_amdgcn_s_waitcnt(0);
        unsigned nloc = b.st[0], nx = b.st[1];
        if (nloc == 0u) { xcd_barrier_complete(bar, b.x, nloc, nx); b.st[0] = nloc; b.st[1] = nx; }
        const unsigned old = xb_add(&bar[XB_XSUB(b.x)], 1u);
        const unsigned gen = old / nloc;
        if (old + 1u == (gen + 1u) * nloc) {
            __builtin_amdgcn_fence(__ATOMIC_RELEASE, "agent");
            asm volatile("s_waitcnt vmcnt(0)" ::: "memory");
            const unsigned og = xb_add(&bar[XB_TOP], 1u);
            const unsigned tg = og / nx;
            if (og + 1u == (tg + 1u) * nx) xb_add(&bar[XB_TOPGEN], 1u);
            else XB_SPIN(xb_ld(&bar[XB_TOPGEN]) == tg, bar);
            __builtin_amdgcn_fence(__ATOMIC_ACQUIRE, "agent");
            xb_add(&bar[XB_XGEN(b.x)], 1u);
            asm volatile("s_waitcnt vmcnt(0)" ::: "memory");
        } else {
            XB_SPIN(xb_ld(&bar[XB_XGEN(b.x)]) == gen, bar);
            __builtin_amdgcn_fence(__ATOMIC_ACQUIRE, "agent");
            asm volatile("s_waitcnt vmcnt(0)" ::: "memory");
        }
    }
    __syncthreads();
}

__global__ void __launch_bounds__(512, 2) hybrid_fwd(Args args) {
    extern __shared__ __attribute__((aligned(16))) unsigned char lds_raw[];
    cg::grid_group grid = cg::this_grid();
    const lp_t lds = (lp_t)lds_raw;
    const int tid = threadIdx.x, lane = tid & 63, wave = __builtin_amdgcn_readfirstlane(tid >> 6);
    const int G = gridDim.x, bx = blockIdx.x, gw = bx * 8 + wave, NGW = G * 8;
    unsigned char* ws = args.ws;
    float* MOD = (float*)(ws + WS_MOD); float* PART = (float*)(ws + WS_PART);
    bf16_t* H = (bf16_t*)(ws + WS_H); bf16_t* HID = (bf16_t*)(ws + WS_BIG); bf16_t* YR = (bf16_t*)(ws + WS_YR);
    {
        if (tid < 16) ((LAS unsigned*)(lds + LDS_BYTES - 64))[tid] = 0u;
        __syncthreads();
    }
    XcdBarrier xbar = xcd_barrier_post((unsigned*)(ws + WS_CTL), (volatile LAS unsigned*)(lds + LDS_BYTES - 64));
    grid.sync();
#define GSYNC() xcd_barrier(xbar)

    {
        LAS float* scr = (LAS float*)(lds + wave * 8704);
        constexpr int I_FFI = 16 * 176, I_FFO = 44 * 32, I_MXI = 16 * 88, I_GLU = 8 * 16, I_MXO = 16 * 32;
        constexpr int I_LAYER = 2 * I_FFI + 2 * I_FFO + I_MXI + I_GLU + I_MXO;
        for (int it = gw; it < DEPTH * I_LAYER; it += NGW) {
            const int l = it / I_LAYER; int r = it % I_LAYER; bf16_t* wl = (bf16_t*)(ws + WS_W + (size_t)l * W_LAYER);
            if (r < I_FFI) { transpose_item(args.in[6] + (size_t)l * DM * 2 * DFF, DM, 2 * DFF, (bf16_t*)((char*)wl + WO_FF1_IN), scr, r / 176, r % 176, 1, lane); continue; } r -= I_FFI;
            if (r < I_FFO) { transpose_item(args.in[7] + (size_t)l * DFF * DM, DFF, DM, (bf16_t*)((char*)wl + WO_FF1_OUT), scr, r / 32, r % 32, 0, lane); continue; } r -= I_FFO;
            if (r < I_MXI) { transpose_item(args.in[10] + (size_t)l * DM * PROJ_W, DM, PROJ_W, (bf16_t*)((char*)wl + WO_MIX_IN), scr, r / 88, r % 88, 2, lane); continue; } r -= I_MXI;
            if (r < I_GLU) { transpose_item(args.in[23] + (size_t)l * 512 * 512, 512, 512, (bf16_t*)((char*)wl + WO_GLU), scr, r / 16, r % 16, 0, lane); continue; } r -= I_GLU;
            if (r < I_MXO) { transpose_item(args.in[24] + (size_t)l * DM * DM, DM, DM, (bf16_t*)((char*)wl + WO_MIX_OUT), scr, r / 32, r % 32, 0, lane); continue; } r -= I_MXO;
            if (r < I_FFI) { transpose_item(args.in[27] + (size_t)l * DM * 2 * DFF, DM, 2 * DFF, (bf16_t*)((char*)wl + WO_FF2_IN), scr, r / 176, r % 176, 1, lane); continue; } r -= I_FFI;
            transpose_item(args.in[28] + (size_t)l * DFF * DM, DFF, DM, (bf16_t*)((char*)wl + WO_FF2_OUT), scr, r / 32, r % 32, 0, lane);
        }
        __syncthreads();
        LAS float* ca = (LAS float*)lds; LAS float* red = (LAS float*)(lds + 16384);
        for (int i = tid; i < NB * DM; i += 512) { const float v = args.in[1][i]; ca[i] = v / (1.0f + expf(-v)); }
        __syncthreads();
        for (int it = bx; it < DEPTH * (NMOD / 64); it += G) {
            const int l = it / (NMOD / 64), cb = it % (NMOD / 64), col = cb * 64 + lane;
            const float* wm = args.in[2] + (size_t)l * DM * NMOD + col;
            float a0 = 0.f, a1 = 0.f, a2 = 0.f, a3 = 0.f;
#pragma unroll 8
            for (int k = wave * 128; k < wave * 128 + 128; ++k) { const float w = wm[(size_t)k * NMOD]; a0 += ca[k] * w; a1 += ca[DM + k] * w; a2 += ca[2 * DM + k] * w; a3 += ca[3 * DM + k] * w; }
            red[(wave * 4 + 0) * 64 + lane] = a0; red[(wave * 4 + 1) * 64 + lane] = a1; red[(wave * 4 + 2) * 64 + lane] = a2; red[(wave * 4 + 3) * 64 + lane] = a3;
            __syncthreads();
            if (tid < 256) { const int b = tid >> 6; float s = args.in[3][(size_t)l * NMOD + col];
#pragma unroll
                for (int w = 0; w < 8; ++w) s += red[(w * 4 + b) * 64 + lane];
                MOD[((size_t)l * NB + b) * NMOD + col] = s; }
            __syncthreads();
        }
    }
    GSYNC();
    finalize_phase(args.in[0], nullptr, nullptr, nullptr, nullptr, 0.f, nullptr, args.in[4], MOD + 0 * DM, MOD + 1 * DM, H, gw, NGW, lane);
    GSYNC();

#pragma unroll 1
    for (int l = 0; l < DEPTH; ++l) {
        const unsigned char* wl = ws + WS_W + (size_t)l * W_LAYER;
        const float* modl = MOD + (size_t)l * NB * NMOD;
#pragma unroll 1
        for (int sub = 0; sub < 3; ++sub) {
#ifdef SKIP_MIX
            if (sub == 1) continue;
#endif
            if (sub != 1) {
                { pg8::Gemm g{H, (const bf16_t*)(wl + (sub == 0 ? WO_FF1_IN : WO_FF2_IN)), M, 2 * DFF, DM, DM, DM}; pg8::StaticOrder S; S.init(M, 2 * DFF, G, bx);
                  EpiSwiglu E{HID, DFF};
#ifndef SKIP_G11
pg8::gemm_phase<EpiSwiglu, true>(lds, g, S, E);
#endif
 }
                GSYNC();
                { pg8::Gemm g{HID, (const bf16_t*)(wl + (sub == 0 ? WO_FF1_OUT : WO_FF2_OUT)), M, DM, DFF, DFF, DFF}; pg8::StaticOrder S; S.init(M, DM, G, bx);
                  EpiYraw E{YR, PART};
#ifndef SKIP_GY1
pg8::gemm_phase<EpiYraw, true>(lds, g, S, E);
#endif
 }
                GSYNC();
            } else {
                bf16_t* QKV = (bf16_t*)(ws + WS_QKV); bf16_t* Zb = (bf16_t*)(ws + WS_Z); bf16_t* Ub = (bf16_t*)(ws + WS_U);
                float* BETA = (float*)(ws + WS_BETA); float* Gg = (float*)(ws + WS_G); float* EGL = (float*)(ws + WS_EGL); float* S5E = (float*)(ws + WS_S5E);
                bf16_t* Dg = (bf16_t*)(ws + WS_D); bf16_t* RTg = (bf16_t*)(ws + WS_RT); bf16_t* QPg = (bf16_t*)(ws + WS_QP); bf16_t* O0Tg = (bf16_t*)(ws + WS_O0T);
                bf16_t* SCg = (bf16_t*)(ws + WS_SC); bf16_t* YS = (bf16_t*)(ws + WS_YS); bf16_t* YCAT = (bf16_t*)(ws + WS_YCAT);
                { pg8::Gemm g{H, (const bf16_t*)(wl + WO_MIX_IN), M, MIXN, DM, DM, DM}; pg8::StaticOrder S; S.init(M, MIXN, G, bx);
                  EpiInproj E{QKV, Zb, Ub, BETA, Gg, args.in[12] + l * 4, args.in[13] + l * 4};
#ifndef SKIP_GI1
pg8::gemm_phase<EpiInproj, true>(lds, g, S, E);
#endif
 }
                GSYNC();

#ifndef SKIP_PRE
                for (int u = bx; u < NUNIT; u += G) gdn_pre_unit(lds, u, QKV, args.in[11] + (size_t)l * 4 * 1536, BETA, Gg, Dg, RTg, QPg, O0Tg, EGL);
#endif

                __syncthreads();

#ifndef SKIP_S5A
                for (int v = gw; v < NB * S5G * NSEG; v += NGW)
                    s5_pass_a(lds + wave * 8704, v, Ub, S5E, args.in[15] + l * 2048, args.in[16] + l * 2048, args.in[17] + l * 32, args.in[18] + (size_t)l * 32768, args.in[19] + (size_t)l * 32768, lane);
#endif

                GSYNC();

#ifndef SKIP_SCAN
                if (bx < 32) gdn_scan(lds, bx, Dg, RTg, EGL, SCg);
#endif


#ifndef SKIP_S5B
                if (bx >= 32) for (int v = (bx - 32) * 8 + wave; v < NB * S5G * NSEG; v += (G - 32) * 8)
                    s5_pass_b(lds + wave * 8704, v, Ub, S5E, args.in[15] + l * 2048, args.in[16] + l * 2048, args.in[17] + l * 32, args.in[18] + (size_t)l * 32768, args.in[19] + (size_t)l * 32768,
                              args.in[20] + (size_t)l * 32768, args.in[21] + (size_t)l * 32768, args.in[22] + l * 512, YS, lane);
#endif

                GSYNC();

#ifndef SKIP_OUT
                for (int p = bx; p < NUNIT / 2; p += G) gdn_out_pair(p, QPg, O0Tg, SCg, Zb, args.in[14] + l * HD, YCAT);
#endif

                { pg8::Gemm g{YS, (const bf16_t*)(wl + WO_GLU), M, 512, 512, 512, 512}; pg8::StaticOrder S; S.init(M, 512, G, bx);
                  EpiGlu E{YS, YCAT};
#ifndef SKIP_GG1
pg8::gemm_phase<EpiGlu, true>(lds, g, S, E);
#endif
 }
                GSYNC();
                { pg8::Gemm g{YCAT, (const bf16_t*)(wl + WO_MIX_OUT), M, DM, DM, DM, DM}; pg8::StaticOrder S; S.init(M, DM, G, bx);
                  EpiYraw E{YR, PART};
#ifndef SKIP_GY2
pg8::gemm_phase<EpiYraw, true>(lds, g, S, E);
#endif
 }
                GSYNC();
            }
            {
                const float* xsrc = (l == 0 && sub == 0) ? args.in[0] : args.out;
                const float* wpost = (sub == 0 ? args.in[5] : (sub == 1 ? args.in[9] : args.in[26])) + l * DM;
                const float* gate = modl + (3 * sub + 2) * DM; const float gs = sub == 1 ? 1.0f : 0.5f;
                const bool last = (l == DEPTH - 1 && sub == 2);
                const int nl = sub == 2 ? l + 1 : l, nsub = sub == 2 ? 0 : sub + 1;
                const float* wpre = last ? nullptr : (nsub == 0 ? args.in[4] : (nsub == 1 ? args.in[8] : args.in[25])) + nl * DM;
                const float* modn = MOD + (size_t)(last ? 0 : nl) * NB * NMOD;
                finalize_phase(xsrc, args.out, YR, PART, gate, gs, wpost, wpre, modn + (3 * nsub) * DM, modn + (3 * nsub + 1) * DM, last ? nullptr : H, gw, NGW, lane);
            }
            GSYNC();
        }
    }
}

extern "C" void kernel_launch(void* const* d_in, const int* in_sizes, int n_in, void* d_out, int out_size, void* d_ws, size_t ws_size, hipStream_t stream) {
    static int grid = 0;
    if (grid == 0) {
        if (n_in != 29 || ws_size < WS_END) { fprintf(stderr, "kernel_launch: unexpected n_in %d or ws %zu\n", n_in, ws_size); grid = -1; return; }
        int dev = 0, cus = 0, per_cu = 0;
        hipGetDevice(&dev); hipDeviceGetAttribute(&cus, hipDeviceAttributeMultiprocessorCount, dev);
        hipFuncSetAttribute((const void*)hybrid_fwd, hipFuncAttributeMaxDynamicSharedMemorySize, LDS_BYTES);
        hipOccupancyMaxActiveBlocksPerMultiprocessor(&per_cu, (const void*)hybrid_fwd, 512, LDS_BYTES);
        if (per_cu < 1) { fprintf(stderr, "kernel_launch: occupancy query says %d blocks per CU\n", per_cu); per_cu = 1; }
        (void)hipGetLastError();
        grid = cus * 1;
    }
    if (grid < 0) return;
    if (hipMemsetAsync((char*)d_ws + WS_CTL, 0, CTL_BYTES, stream) != hipSuccess) { fprintf(stderr, "memset failed\n"); return; }
    Args a{};
    for (int i = 0; i < 29; ++i) a.in[i] = (const float*)d_in[i];
    a.out = (float*)d_out; a.ws = (unsigned char*)d_ws;
    void* kargs[] = {&a};
    hipError_t e = hipLaunchCooperativeKernel((const void*)hybrid_fwd, dim3(grid), dim3(512), kargs, LDS_BYTES, stream);
    if (e != hipSuccess) fprintf(stderr, "cooperative launch failed: %s (grid %d)\n", hipGetErrorString(e), grid);
}
```

```cpp
#include <hip/hip_runtime.h>
#include <hip/hip_cooperative_groups.h>
#include <cstdio>
#include <cstdint>
namespace cg = cooperative_groups;

#define LAS __attribute__((address_space(3)))
typedef unsigned short bf16_t;
typedef short bf16x8 __attribute__((ext_vector_type(8)));
typedef float f32x4 __attribute__((ext_vector_type(4)));
typedef float f32x2 __attribute__((ext_vector_type(2)));
typedef unsigned u32x4 __attribute__((ext_vector_type(4)));
typedef unsigned u32x2 __attribute__((ext_vector_type(2)));
typedef LAS unsigned char* lp_t;

constexpr int DM = 1024, NB = 4, SEQ = 8192, M = NB * SEQ, DEPTH = 2;
constexpr int DFF = 2816, NH = 4, HD = 128, CH = 64, NCH = SEQ / CH;
constexpr int NUNIT = NB * NH * NCH;
constexpr int S5G = 32, S5P = 64, S5H = 16, LSEG = 256, NSEG = SEQ / LSEG;
constexpr int NMOD = 9 * DM;
constexpr int PROJ_W = 2568, MIXN = 2816;
constexpr float EPS = 1e-6f;

namespace pg8 {
constexpr int BM = 256, BK = 64, HALF = 128, HTB = HALF * BK * 2, STAGE_BYTES = 8 * HTB, NXCD = 8, WGM = 8;
__device__ __forceinline__ int lds_byte(int r, int c) { const int st = (r >> 4) * 2 + (c >> 5), rr = r & 15, cc = c & 31, ob = rr * 64 + cc * 2; return st * 1024 + (ob ^ (((ob >> 9) & 1) << 5)); }
__device__ __forceinline__ void stage_rc(int b, int& R, int& C) { const int st = b / 1024, sb = b % 1024, swz = sb ^ (((sb >> 9) & 1) << 5); R = (st >> 1) * 16 + swz / 64; C = (st & 1) * 32 + (swz % 64) / 2; }
__device__ __forceinline__ int perm32(int rho) { const int n = rho >> 4, i = rho & 15; return 8 * (i >> 2) + 4 * n + (i & 3); }
struct Unit { int pm, pn; };
struct Gemm { const bf16_t* A; const bf16_t* Bt; int M, N, K, lda, ldb; };
struct StaticOrder {
    int nM, nN, nwg, G, c;
    __device__ void init(int M_, int N_, int G_, int c_) { nM = M_ / BM; nN = N_ / BM; nwg = nM * nN; G = G_; c = c_; }
    __device__ bool next(int i, Unit& u) const {
        const long L = (long)i * G + c; if (L >= nwg) return false;
        int wgid = (int)L; { const int q = nwg / NXCD, r = nwg % NXCD, xcd = wgid % NXCD, off = wgid / NXCD; wgid = (xcd < r ? xcd * (q + 1) : r * (q + 1) + (xcd - r) * q) + off; }
        const int nig = WGM * nN, gid = wgid / nig, fm = gid * WGM, gsz = (nM - fm) < WGM ? (nM - fm) : WGM;
        u.pm = fm + ((wgid % nig) % gsz); u.pn = (wgid % nig) / gsz; return true;
    }
};
typedef __bf16 bf16x2_t __attribute__((ext_vector_type(2)));
__device__ __forceinline__ unsigned cvt_pk_bf16(float lo, float hi) { f32x2 v = {lo, hi}; bf16x2_t b = __builtin_convertvector(v, bf16x2_t); return __builtin_bit_cast(unsigned, b); }

template <class Epi, bool ALIGN_EPI>
__device__ __forceinline__ void gemm_phase(lp_t lds, const Gemm g, const StaticOrder& S, const Epi& E) {
    int tid_ = threadIdx.x; asm volatile("" : "+v"(tid_));
    const int tid = tid_, wid = __builtin_amdgcn_readfirstlane(tid >> 6), lane = tid & 63, wr = wid >> 2, wc = wid & 3, fr = lane & 15, fq = lane >> 4;
    const int K = g.K, nt = K / BK;
    unsigned voffA[2], voffB[2];
#pragma unroll
    for (int i = 0; i < 2; ++i) { int R, C; stage_rc(tid * 16 + i * 8192, R, C); const int Rb = Epi::PERM ? ((R & ~31) + perm32(R & 31)) : R;
        voffA[i] = (unsigned)(R * g.lda + C) * 2u; voffB[i] = (unsigned)(Rb * g.ldb + C) * 2u; }
    const size_t kstep = (size_t)(BK * 2);
    const size_t hsA = (size_t)HALF * g.lda * 2, hsB = (size_t)HALF * g.ldb * 2, tsA = 2 * hsA, tsB = 2 * hsB;
    const unsigned ldsw = (unsigned)wid * 1024u;
    const int aoff = lds_byte(wr * 64 + fr, fq * 8), boff = lds_byte(wc * 32 + fr, fq * 8);
#define PG8_SA(b, h) (((b) * 2 + (h)) * HTB)
#define PG8_SB(b, h) ((4 + (b) * 2 + (h)) * HTB)
#define PG8_STAGE(bufoff, gbase, voff) do { _Pragma("unroll") for (int _i = 0; _i < 2; ++_i) \
        __builtin_amdgcn_global_load_lds((const unsigned*)((const char*)(gbase) + (voff)[_i]), (LAS unsigned*)(lds + (bufoff) + ldsw + _i * 8192), 16, 0, 0); } while (0)
#define PG8_LDA(dst, b, h) do { _Pragma("unroll") for (int m = 0; m < 4; ++m) _Pragma("unroll") for (int k = 0; k < 2; ++k) dst[m][k] = *(const LAS bf16x8*)(lds + PG8_SA(b, h) + aoff + m * 2048 + k * 1024); } while (0)
#define PG8_LDB(dst, b, h) do { _Pragma("unroll") for (int n = 0; n < 2; ++n) _Pragma("unroll") for (int k = 0; k < 2; ++k) dst[n][k] = *(const LAS bf16x8*)(lds + PG8_SB(b, h) + boff + n * 2048 + k * 1024); } while (0)
#define PG8_MMA(ai, bj, At, Bt) do { __builtin_amdgcn_s_setprio(1); _Pragma("unroll") for (int m = 0; m < 4; ++m) _Pragma("unroll") for (int n = 0; n < 2; ++n) _Pragma("unroll") for (int k = 0; k < 2; ++k) \
        acc[ai][bj][m][n] = __builtin_amdgcn_mfma_f32_16x16x32_bf16(Bt[n][k], At[m][k], acc[ai][bj][m][n], 0, 0, 0); __builtin_amdgcn_s_setprio(0); } while (0)
#define PG8_WAIT_V(n) asm volatile("s_waitcnt vmcnt(" #n ")" ::: "memory")
#define PG8_WAIT_L(n) asm volatile("s_waitcnt lgkmcnt(" #n ")" ::: "memory")
#define PG8_BAR __builtin_amdgcn_s_barrier()
#define PG8_SCHED __builtin_amdgcn_sched_barrier(0)
    Unit cur, nxt; int ui = 0;
    if (!S.next(0, cur)) return;
    f32x4 acc[2][2][4][2];
#pragma unroll
    for (int a = 0; a < 2; ++a)
#pragma unroll
        for (int b = 0; b < 2; ++b)
#pragma unroll
            for (int m = 0; m < 4; ++m)
#pragma unroll
                for (int n = 0; n < 2; ++n) acc[a][b][m][n] = (f32x4){0.f, 0.f, 0.f, 0.f};
    bf16x8 At[4][2], B0[2][2], B1[2][2];
    const char* cA = (const char*)g.A + (size_t)cur.pm * tsA; const char* cB = (const char*)g.Bt + (size_t)cur.pn * tsB;
    PG8_STAGE(PG8_SB(0, 0), cB, voffB); PG8_STAGE(PG8_SB(0, 1), cB + hsB, voffB); PG8_STAGE(PG8_SA(0, 0), cA, voffA); PG8_STAGE(PG8_SA(0, 1), cA + hsA, voffA);
    if (wr == 1) PG8_BAR;
    PG8_WAIT_V(2); PG8_BAR;
    PG8_STAGE(PG8_SB(1, 0), cB + kstep, voffB); PG8_STAGE(PG8_SA(1, 0), cA + kstep, voffA); PG8_STAGE(PG8_SB(1, 1), cB + hsB + kstep, voffB);
    PG8_WAIT_V(6); PG8_BAR;
    for (;;) {
        const bool has_next = S.next(ui + 1, nxt);
        const char* nA = has_next ? (const char*)g.A + (size_t)nxt.pm * tsA : cA; const char* nB = has_next ? (const char*)g.Bt + (size_t)nxt.pn * tsB : cB;
        for (int t = 0; t < nt; t += 2) {
            const bool last = (t == nt - 2);
            const char* a1 = cA + (size_t)(t + 1) * kstep;
            const char* a2 = last ? nA : cA + (size_t)(t + 2) * kstep; const char* b2 = last ? nB : cB + (size_t)(t + 2) * kstep;
            const char* a3 = a2 + kstep; const char* b3 = b2 + kstep;
            PG8_LDB(B0, 0, 0); PG8_LDB(B1, 0, 1); PG8_SCHED; PG8_LDA(At, 0, 0); PG8_STAGE(PG8_SA(1, 1), a1 + hsA, voffA);
            PG8_WAIT_V(8); PG8_WAIT_L(0); PG8_BAR; PG8_MMA(0, 0, At, B0); PG8_MMA(0, 1, At, B1); PG8_BAR; PG8_SCHED;
            PG8_LDA(At, 0, 1); PG8_STAGE(PG8_SB(0, 0), b2, voffB); PG8_STAGE(PG8_SB(0, 1), b2 + hsB, voffB); PG8_STAGE(PG8_SA(0, 0), a2, voffA);
            PG8_WAIT_V(8); PG8_WAIT_L(0); PG8_BAR; PG8_MMA(1, 0, At, B0); PG8_MMA(1, 1, At, B1); PG8_BAR; PG8_SCHED;
            PG8_LDB(B0, 1, 0); PG8_LDB(B1, 1, 1); PG8_SCHED; PG8_LDA(At, 1, 0); PG8_STAGE(PG8_SA(0, 1), a2 + hsA, voffA);
            PG8_WAIT_V(8); PG8_WAIT_L(0); PG8_BAR; PG8_MMA(0, 0, At, B0); PG8_MMA(0, 1, At, B1); PG8_BAR; PG8_SCHED;
            PG8_LDA(At, 1, 1); PG8_STAGE(PG8_SB(1, 0), b3, voffB); PG8_STAGE(PG8_SB(1, 1), b3 + hsB, voffB); PG8_STAGE(PG8_SA(1, 0), a3, voffA);
            PG8_WAIT_V(8); PG8_WAIT_L(0); PG8_BAR; PG8_MMA(1, 0, At, B0); PG8_MMA(1, 1, At, B1); PG8_BAR; PG8_SCHED;
        }
        if constexpr (ALIGN_EPI) { if (wr == 0) PG8_BAR; }
        E(acc, cur, wr, wc, fr, fq);
        if (!has_next) break;
#pragma unroll
        for (int a = 0; a < 2; ++a)
#pragma unroll
            for (int b = 0; b < 2; ++b)
#pragma unroll
                for (int m = 0; m < 4; ++m)
#pragma unroll
                    for (int n = 0; n < 2; ++n) acc[a][b][m][n] = (f32x4){0.f, 0.f, 0.f, 0.f};
        cur = nxt; cA = nA; cB = nB; ++ui;
        if constexpr (ALIGN_EPI) { if (wr == 1) PG8_BAR; }
    }
    PG8_WAIT_V(0);
    if constexpr (!ALIGN_EPI) { if (wr == 0) PG8_BAR; }
    PG8_BAR;
#undef PG8_SA
#undef PG8_SB
#undef PG8_STAGE
#undef PG8_LDA
#undef PG8_LDB
#undef PG8_MMA
#undef PG8_WAIT_V
#undef PG8_WAIT_L
#undef PG8_BAR
#undef PG8_SCHED
}
}
using pg8::cvt_pk_bf16;

__device__ __forceinline__ float bf2f(unsigned v) { return __uint_as_float(v << 16); }
__device__ __forceinline__ float bflo(unsigned w) { return __uint_as_float(w << 16); }
__device__ __forceinline__ float bfhi(unsigned w) { return __uint_as_float(w & 0xffff0000u); }
__device__ __forceinline__ unsigned short f2bf(float f) { return (unsigned short)(cvt_pk_bf16(f, 0.f) & 0xffffu); }
__device__ __forceinline__ float sigmoidf_(float x) { return 1.0f / (1.0f + __expf(-x)); }
__device__ __forceinline__ float siluf_(float x) { return x * sigmoidf_(x); }
__device__ __forceinline__ float gelu_tanh(float y) { const float z = 0.7978845608028654f * (y + 0.044715f * y * y * y); const float t = 1.0f - 2.0f / (1.0f + __expf(2.0f * z)); return 0.5f * y * (1.0f + t); }
__device__ __forceinline__ float wave_sum(float v) {
#pragma unroll
    for (int o = 1; o < 64; o <<= 1) v += __shfl_xor(v, o);
    return v;
}
#define LDS_WAIT() asm volatile("s_waitcnt lgkmcnt(0)" ::: "memory")

struct EpiSwiglu {
    static constexpr bool PERM = true;
    bf16_t* O; int ldc;
    __device__ __forceinline__ void operator()(const f32x4 (&acc)[2][2][4][2], const pg8::Unit& u, int wr, int wc, int fr, int fq) const {
        const int row0 = u.pm * 256 + wr * 64 + fr, col0 = u.pn * 128 + wc * 32 + 8 * fq;
#pragma unroll
        for (int ai = 0; ai < 2; ++ai)
#pragma unroll
            for (int m = 0; m < 4; ++m) {
                const f32x4 g0 = acc[ai][0][m][0], g1 = acc[ai][0][m][1], u0 = acc[ai][1][m][0], u1 = acc[ai][1][m][1];
                u32x4 w;
                w.x = cvt_pk_bf16(siluf_(g0[0]) * u0[0], siluf_(g0[1]) * u0[1]); w.y = cvt_pk_bf16(siluf_(g0[2]) * u0[2], siluf_(g0[3]) * u0[3]);
                w.z = cvt_pk_bf16(siluf_(g1[0]) * u1[0], siluf_(g1[1]) * u1[1]); w.w = cvt_pk_bf16(siluf_(g1[2]) * u1[2], siluf_(g1[3]) * u1[3]);
                *(u32x4*)(O + (size_t)(row0 + ai * 128 + m * 16) * ldc + col0) = w;
                asm volatile("" ::: "memory");
            }
    }
};
struct EpiYraw {
    static constexpr bool PERM = true;
    bf16_t* O; float* part;
    __device__ __forceinline__ void operator()(const f32x4 (&acc)[2][2][4][2], const pg8::Unit& u, int wr, int wc, int fr, int fq) const {
        const int row0 = u.pm * 256 + wr * 64 + fr, col0 = u.pn * 256 + wc * 32 + 8 * fq;
#pragma unroll
        for (int ai = 0; ai < 2; ++ai)
#pragma unroll
            for (int m = 0; m < 4; ++m) {
                const int row = row0 + ai * 128 + m * 16; float ss = 0.f;
#pragma unroll
                for (int bj = 0; bj < 2; ++bj) { const f32x4 v0 = acc[ai][bj][m][0], v1 = acc[ai][bj][m][1];
                    ss += (v0[0] * v0[0] + v0[1] * v0[1]) + (v0[2] * v0[2] + v0[3] * v0[3]) + (v1[0] * v1[0] + v1[1] * v1[1]) + (v1[2] * v1[2] + v1[3] * v1[3]);
                    u32x4 w; w.x = cvt_pk_bf16(v0[0], v0[1]); w.y = cvt_pk_bf16(v0[2], v0[3]); w.z = cvt_pk_bf16(v1[0], v1[1]); w.w = cvt_pk_bf16(v1[2], v1[3]);
                    *(u32x4*)(O + (size_t)row * DM + col0 + bj * 128) = w; }
                ss += __shfl_xor(ss, 16); ss += __shfl_xor(ss, 32);
                if (fq == 0) part[(size_t)row * 16 + u.pn * 4 + wc] = ss;
                asm volatile("" ::: "memory");
            }
    }
};
struct EpiInproj {
    static constexpr bool PERM = true;
    bf16_t *QKV, *Z, *U; float *BETA, *G; const float *a_log, *dt_bias;
    __device__ __forceinline__ void operator()(const f32x4 (&acc)[2][2][4][2], const pg8::Unit& u, int wr, int wc, int fr, int fq) const {
        const int row0 = u.pm * 256 + wr * 64 + fr;
        if (u.pn == 10) {
            if (wc == 0 && fq == 0) {
                const f32x4 al = *(const f32x4*)a_log, db = *(const f32x4*)dt_bias;
#pragma unroll
                for (int ai = 0; ai < 2; ++ai)
#pragma unroll
                    for (int m = 0; m < 4; ++m) { const int row = row0 + ai * 128 + m * 16; const f32x4 bi = acc[ai][0][m][0], an = acc[ai][0][m][1]; f32x4 bo, go;
#pragma unroll
                        for (int j = 0; j < 4; ++j) { bo[j] = 1.0f / (1.0f + expf(-bi[j])); const float xx = an[j] + db[j]; const float sp = xx > 20.f ? xx : log1pf(expf(xx)); go[j] = -expf(al[j]) * sp; }
                        *(f32x4*)(BETA + (size_t)row * 4) = bo; *(f32x4*)(G + (size_t)row * 4) = go; asm volatile("" ::: "memory"); }
            }
            return;
        }
        bf16_t* base; int ldc, colt;
        if (u.pn < 6) { base = QKV; ldc = 1536; colt = u.pn * 256; } else if (u.pn < 8) { base = Z; ldc = 512; colt = (u.pn - 6) * 256; } else { base = U; ldc = 512; colt = (u.pn - 8) * 256; }
        const int col0 = colt + wc * 32 + 8 * fq;
#pragma unroll
        for (int ai = 0; ai < 2; ++ai)
#pragma unroll
            for (int m = 0; m < 4; ++m)
#pragma unroll
                for (int bj = 0; bj < 2; ++bj) { const f32x4 v0 = acc[ai][bj][m][0], v1 = acc[ai][bj][m][1];
                    u32x4 w; w.x = cvt_pk_bf16(v0[0], v0[1]); w.y = cvt_pk_bf16(v0[2], v0[3]); w.z = cvt_pk_bf16(v1[0], v1[1]); w.w = cvt_pk_bf16(v1[2], v1[3]);
                    *(u32x4*)(base + (size_t)(row0 + ai * 128 + m * 16) * ldc + col0 + bj * 128) = w; asm volatile("" ::: "memory"); }
    }
};
struct EpiGlu {
    static constexpr bool PERM = true;
    const bf16_t* YS; bf16_t* YCAT;
    __device__ __forceinline__ void operator()(const f32x4 (&acc)[2][2][4][2], const pg8::Unit& u, int wr, int wc, int fr, int fq) const {
        const int row0 = u.pm * 256 + wr * 64 + fr, col0 = u.pn * 256 + wc * 32 + 8 * fq;
#pragma unroll
        for (int ai = 0; ai < 2; ++ai)
#pragma unroll
            for (int m = 0; m < 4; ++m)
#pragma unroll
                for (int bj = 0; bj < 2; ++bj) { const int row = row0 + ai * 128 + m * 16, col = col0 + bj * 128;
                    const u32x4 y = *(const u32x4*)(YS + (size_t)row * 512 + col); const f32x4 v0 = acc[ai][bj][m][0], v1 = acc[ai][bj][m][1];
                    u32x4 w; w.x = cvt_pk_bf16(bflo(y.x) * sigmoidf_(v0[0]), bfhi(y.x) * sigmoidf_(v0[1])); w.y = cvt_pk_bf16(bflo(y.y) * sigmoidf_(v0[2]), bfhi(y.y) * sigmoidf_(v0[3]));
                    w.z = cvt_pk_bf16(bflo(y.z) * sigmoidf_(v1[0]), bfhi(y.z) * sigmoidf_(v1[1])); w.w = cvt_pk_bf16(bflo(y.w) * sigmoidf_(v1[2]), bfhi(y.w) * sigmoidf_(v1[3]));
                    *(u32x4*)(YCAT + (size_t)row * DM + 512 + col) = w; asm volatile("" ::: "memory"); }
    }
};

constexpr size_t MiB = 1u << 20;
constexpr size_t W_FF_IN = (size_t)2 * DFF * DM * 2, W_FF_OUT = (size_t)DM * DFF * 2, W_MIX_IN = (size_t)MIXN * DM * 2, W_GLU = 512 * 512 * 2, W_MIX_OUT = (size_t)DM * DM * 2;
constexpr size_t WO_FF1_IN = 0, WO_FF1_OUT = WO_FF1_IN + W_FF_IN, WO_MIX_IN = WO_FF1_OUT + W_FF_OUT, WO_GLU = WO_MIX_IN + W_MIX_IN, WO_MIX_OUT = WO_GLU + W_GLU,
                 WO_FF2_IN = WO_MIX_OUT + W_MIX_OUT, WO_FF2_OUT = WO_FF2_IN + W_FF_IN, W_LAYER = WO_FF2_OUT + W_FF_OUT;
static_assert(W_LAYER * 2 <= 84 * MiB, "weights");
constexpr size_t WS_W = 0, WS_H = 84 * MiB, WS_BIG = 148 * MiB, WS_YR = 324 * MiB, WS_EX = 388 * MiB, WS_SMALL = 500 * MiB, WS_END = 512 * MiB;
constexpr size_t WS_QKV = WS_BIG, WS_Z = WS_BIG + 96 * MiB, WS_U = WS_BIG + 128 * MiB;
constexpr size_t WS_SC = WS_BIG;
constexpr size_t WS_D = WS_EX, WS_RT = WS_YR;
constexpr size_t WS_QP = WS_H, WS_O0T = WS_H + 32 * MiB;
constexpr size_t WS_YS = WS_EX + 64 * MiB;
constexpr size_t WS_YCAT = WS_EX;
constexpr size_t WS_PART = WS_SMALL, WS_MOD = WS_PART + 2 * MiB, WS_BETA = WS_MOD + 1 * MiB, WS_G = WS_BETA + 1 * MiB, WS_EGL = WS_G + 1 * MiB, WS_S5E = WS_EGL + 1 * MiB;
static_assert(WS_S5E + 2 * MiB <= WS_END, "small");
constexpr int LDS_BYTES = 147456;
#ifndef REP_A
#define REP_A 1
#endif
#ifndef REP_B
#define REP_B 1
#endif
constexpr size_t WS_CTL = WS_SMALL + 10 * MiB, CTL_BYTES = 16384;

struct Args { const float* in[29]; float* out; unsigned char* ws; int rep_a, rep_b; };

__device__ __forceinline__ int src_col(int maptype, int n) {
    if (maptype == 0) return n;
    if (maptype == 1) { const int t = n >> 8, w = n & 255; return (w < 128) ? t * 128 + w : DFF + t * 128 + (w - 128); }
    return n < 2048 ? n : (n < 2560 ? n + 8 : (n < 2568 ? n - 512 : -1));
}
__device__ __forceinline__ void transpose_item(const float* W, int K, int N, bf16_t* WT, LAS float* scr, int kb, int nb, int maptype, int lane) {
    const int k0 = 64 * kb, n0 = 32 * nb; const int sc = src_col(maptype, n0 + (lane & 31));
#pragma unroll 8
    for (int i = 0; i < 32; ++i) { const int kk = 2 * i + (lane >> 5); scr[kk * 33 + (lane & 31)] = sc >= 0 ? W[(size_t)(k0 + kk) * N + sc] : 0.f; }
    LDS_WAIT(); asm volatile("" ::: "memory");
    const int c = lane & 7;
#pragma unroll
    for (int j = 0; j < 4; ++j) { const int n = (lane >> 3) + 8 * j; const LAS float* s = scr + (8 * c) * 33 + n;
        u32x4 o; o.x = cvt_pk_bf16(s[0 * 33], s[1 * 33]); o.y = cvt_pk_bf16(s[2 * 33], s[3 * 33]); o.z = cvt_pk_bf16(s[4 * 33], s[5 * 33]); o.w = cvt_pk_bf16(s[6 * 33], s[7 * 33]);
        *(u32x4*)(WT + (size_t)(n0 + n) * K + k0 + 8 * c) = o; }
    LDS_WAIT(); asm volatile("" ::: "memory");
}

__device__ __forceinline__ void finalize_phase(const float* xsrc, float* xdst, const bf16_t* yraw, const float* part, const float* gate  , float gs, const float* wpost,
                                               const float* wpre, const float* shift, const float* scale, bf16_t* H, int gw, int NGW, int lane) {
    asm volatile("" : "+v"(lane));
    for (int m = gw; m < M; m += NGW) {
        const int b = m / SEQ;
        f32x4 x[4];
#pragma unroll
        for (int j = 0; j < 4; ++j) x[j] = *(const f32x4*)(xsrc + (size_t)m * DM + 4 * lane + 256 * j);
        if (yraw) {
            float ss = 0.f;
#pragma unroll
            for (int q = 0; q < 4; ++q) { const f32x4 p = *(const f32x4*)(part + (size_t)m * 16 + 4 * q); ss += (p[0] + p[1]) + (p[2] + p[3]); }
            const float rstd = rsqrtf(ss * (1.0f / DM) + EPS) * gs;
#pragma unroll
            for (int j = 0; j < 4; ++j) { const int col = 4 * lane + 256 * j; const u32x2 y = *(const u32x2*)(yraw + (size_t)m * DM + col);
                const f32x4 gt = *(const f32x4*)(gate + (size_t)b * NMOD + col), wp = *(const f32x4*)(wpost + col);
                x[j][0] += gt[0] * wp[0] * rstd * bflo(y.x); x[j][1] += gt[1] * wp[1] * rstd * bfhi(y.x); x[j][2] += gt[2] * wp[2] * rstd * bflo(y.y); x[j][3] += gt[3] * wp[3] * rstd * bfhi(y.y);
                *(f32x4*)(xdst + (size_t)m * DM + col) = x[j]; }
        }
        if (H) {
            float s2 = 0.f;
#pragma unroll
            for (int j = 0; j < 4; ++j) s2 += (x[j][0] * x[j][0] + x[j][1] * x[j][1]) + (x[j][2] * x[j][2] + x[j][3] * x[j][3]);
            const float r2 = rsqrtf(wave_sum(s2) * (1.0f / DM) + EPS);
#pragma unroll
            for (int j = 0; j < 4; ++j) { const int col = 4 * lane + 256 * j; const f32x4 wp = *(const f32x4*)(wpre + col), sh = *(const f32x4*)(shift + (size_t)b * NMOD + col), sc = *(const f32x4*)(scale + (size_t)b * NMOD + col);
                u32x2 o; o.x = cvt_pk_bf16(x[j][0] * r2 * wp[0] * (1.f + sc[0]) + sh[0], x[j][1] * r2 * wp[1] * (1.f + sc[1]) + sh[1]);
                o.y = cvt_pk_bf16(x[j][2] * r2 * wp[2] * (1.f + sc[2]) + sh[2], x[j][3] * r2 * wp[3] * (1.f + sc[3]) + sh[3]);
                *(u32x2*)(H + (size_t)m * DM + col) = o; }
        }
    }
}

__device__ __forceinline__ f32x4 mma_nt(lp_t A, int lda_b, lp_t B, int ldb_b, int nkt, int fr, int fq, f32x4 acc) {
    for (int kt = 0; kt < nkt; ++kt) {
        const bf16x8 a = *(const LAS bf16x8*)(A + fr * lda_b + (kt * 32 + fq * 8) * 2);
        const bf16x8 b = *(const LAS bf16x8*)(B + fr * ldb_b + (kt * 32 + fq * 8) * 2);
        acc = __builtin_amdgcn_mfma_f32_16x16x32_bf16(a, b, acc, 0, 0, 0);
    }
    return acc;
}

constexpr int GP_KN = 0, GP_QS = 17408, GP_V = 34816, GP_KST = 51200, GP_ATT = 67584, GP_A = 76800, GP_TT = 93184, GP_GC = 130048, GP_BETA = 130304, GP_BG = 130560, GP_END = 130816;
constexpr int LD136 = 272, LD72 = 144, LDV = 256, LDKS = 128;
__device__ __forceinline__ void gdn_pre_unit(lp_t lds, int u, const bf16_t* QKV, const float* convw, const float* BETA, const float* G,
                                             bf16_t* Dg, bf16_t* RTg, bf16_t* QPg, bf16_t* O0Tg, float* EGL) {
    int tid_ = threadIdx.x; asm volatile("" : "+v"(tid_));
    const int tid = tid_, wid = __builtin_amdgcn_readfirstlane(tid >> 6), lane = tid & 63, fr = lane & 15, fq = lane >> 4;
    const int b = u >> 9, h = (u >> 7) & 3, c = u & 127;
    const size_t row0 = (size_t)b * SEQ + (size_t)c * CH;
    LAS float* sGC = (LAS float*)(lds + GP_GC); LAS float* sBE = (LAS float*)(lds + GP_BETA);
    if (wid == 0) {
        float v = G[(row0 + lane) * 4 + h];
#ifdef DBG_CONST_GB
        v = -0.01f;
#endif
#pragma unroll
        for (int o = 1; o < 64; o <<= 1) { const float t = __shfl_up(v, o); if (lane >= o) v += t; }
        float be = BETA[(row0 + lane) * 4 + h];
#ifdef DBG_CONST_GB
        be = 0.5f;
#endif
        sGC[lane] = v; sBE[lane] = be; *(LAS float*)(lds + GP_BG + lane * 4) = be * expf(v);
    }
    __syncthreads();
    const float gl = sGC[63];
    {
        const int i = tid >> 3, d0 = (tid & 7) * 16; const float gci = sGC[i];
#pragma unroll 1
        for (int part = 0; part < 3; ++part) {
            const int ch0 = part * 512 + h * 128 + d0;
            float a[16];
#pragma unroll
            for (int e = 0; e < 16; ++e) a[e] = 0.f;
#pragma unroll
            for (int j = 0; j < 4; ++j) {
                const int t = c * CH + i - 3 + j;
                if (t >= 0) {
                    const bf16_t* src = QKV + ((size_t)b * SEQ + t) * 1536 + ch0; const float* wj = convw + j * 1536 + ch0;
                    const u32x4 x0 = *(const u32x4*)src, x1 = *(const u32x4*)(src + 8);
                    const f32x4 w0 = *(const f32x4*)wj, w1 = *(const f32x4*)(wj + 4), w2 = *(const f32x4*)(wj + 8), w3 = *(const f32x4*)(wj + 12);
                    a[0] += w0[0] * bflo(x0.x); a[1] += w0[1] * bfhi(x0.x); a[2] += w0[2] * bflo(x0.y); a[3] += w0[3] * bfhi(x0.y);
                    a[4] += w1[0] * bflo(x0.z); a[5] += w1[1] * bfhi(x0.z); a[6] += w1[2] * bflo(x0.w); a[7] += w1[3] * bfhi(x0.w);
                    a[8] += w2[0] * bflo(x1.x); a[9] += w2[1] * bfhi(x1.x); a[10] += w2[2] * bflo(x1.y); a[11] += w2[3] * bfhi(x1.y);
                    a[12] += w3[0] * bflo(x1.z); a[13] += w3[1] * bfhi(x1.z); a[14] += w3[2] * bflo(x1.w); a[15] += w3[3] * bfhi(x1.w);
                }
            }
            float ss = 0.f;
#pragma unroll
            for (int e = 0; e < 16; ++e) { a[e] = a[e] / (1.0f + expf(-a[e])); ss += a[e] * a[e]; }
            ss += __shfl_xor(ss, 1); ss += __shfl_xor(ss, 2); ss += __shfl_xor(ss, 4);
            float sc = 1.f;
            if (part == 0) sc = rsqrtf(ss + EPS) * 0.08838834764831845f; else if (part == 1) sc = rsqrtf(ss + EPS);
            const lp_t dst = lds + (part == 0 ? GP_QS : (part == 1 ? GP_KN : GP_V)) + i * (part == 2 ? LDV : LD136) + d0 * 2;
            u32x4 o0, o1;
            o0.x = cvt_pk_bf16(a[0] * sc, a[1] * sc); o0.y = cvt_pk_bf16(a[2] * sc, a[3] * sc); o0.z = cvt_pk_bf16(a[4] * sc, a[5] * sc); o0.w = cvt_pk_bf16(a[6] * sc, a[7] * sc);
            o1.x = cvt_pk_bf16(a[8] * sc, a[9] * sc); o1.y = cvt_pk_bf16(a[10] * sc, a[11] * sc); o1.z = cvt_pk_bf16(a[12] * sc, a[13] * sc); o1.w = cvt_pk_bf16(a[14] * sc, a[15] * sc);
            *(LAS u32x4*)dst = o0; *(LAS u32x4*)(dst + 16) = o1;
            if (part == 1) { const float ks = sc * expf(gl - gci);
#pragma unroll
                for (int e = 0; e < 16; ++e) *(LAS unsigned short*)(lds + GP_KST + (d0 + e) * LDKS + i * 2) = f2bf(a[e] * ks); }
        }
    }
    __syncthreads();
    {
#pragma unroll 1
        for (int q = 0; q < 4; ++q) {
            const int idx = wid * 4 + q, isq = idx >> 4, mt = (idx >> 2) & 3, nt = idx & 3;
            f32x4 acc = (f32x4){0.f, 0.f, 0.f, 0.f};
            acc = mma_nt(lds + (isq ? GP_QS : GP_KN) + mt * 16 * LD136, LD136, lds + GP_KN + nt * 16 * LD136, LD136, 4, fr, fq, acc);
            const int jc = nt * 16 + fr; const float gcj = sGC[jc];
#pragma unroll
            for (int jj = 0; jj < 4; ++jj) { const int i = mt * 16 + 4 * fq + jj; const float dec = expf(fminf(sGC[i] - gcj, 0.f));
                if (isq) *(LAS unsigned short*)(lds + GP_ATT + i * LD72 + jc * 2) = f2bf(i >= jc ? acc[jj] * dec : 0.f);
                else *(LAS float*)(lds + GP_A + (i * 64 + jc) * 4) = (i > jc) ? sBE[i] * acc[jj] * dec : 0.f; }
        }
    }
    __syncthreads();
    if (wid < 4) {
        const int col = wid * 64 + lane;
        unsigned lbA = (unsigned)(size_t)(lds + GP_A), lbS = (unsigned)(size_t)(lds + (wid < 2 ? GP_BETA : GP_BG));
        asm volatile("" : "+v"(lbA), "+v"(lbS));
        const lp_t pA = (lp_t)lbA, pS = (lp_t)lbS;
        const lp_t pR = (wid < 2) ? (lds + GP_V + col * 2) : (lds + GP_KN + (col - 128) * 2);
        float T[64];
#pragma unroll
        for (int i = 0; i < 64; ++i) {
            float acc = *(const LAS float*)(pS + i * 4) * bf2f(*(const LAS unsigned short*)(pR + i * (wid < 2 ? LDV : LD136)));
#pragma unroll
#ifdef DBG_NOSOLVE
            for (int j4 = 0; j4 < 0; ++j4) { const f32x4 a = *(const LAS f32x4*)(pA + (i * 64 + j4 * 4) * 4);
#else
            for (int j4 = 0; j4 < (i + 3) / 4; ++j4) { const f32x4 a = *(const LAS f32x4*)(pA + (i * 64 + j4 * 4) * 4);
#endif
                acc = __builtin_fmaf(-a[0], T[j4 * 4], acc);
                if (j4 * 4 + 1 < i) acc = __builtin_fmaf(-a[1], T[j4 * 4 + 1], acc);
                if (j4 * 4 + 2 < i) acc = __builtin_fmaf(-a[2], T[j4 * 4 + 2], acc);
                if (j4 * 4 + 3 < i) acc = __builtin_fmaf(-a[3], T[j4 * 4 + 3], acc); }
            T[i] = acc;
            asm volatile("" ::: "memory");
        }
        const lp_t pT = lds + GP_TT + col * LD72;
#pragma unroll
        for (int q = 0; q < 8; ++q) { u32x4 o; o.x = cvt_pk_bf16(T[8 * q], T[8 * q + 1]); o.y = cvt_pk_bf16(T[8 * q + 2], T[8 * q + 3]); o.z = cvt_pk_bf16(T[8 * q + 4], T[8 * q + 5]); o.w = cvt_pk_bf16(T[8 * q + 6], T[8 * q + 7]);
            *(LAS u32x4*)(pT + q * 16) = o; }
    }
    __syncthreads();
    {
        bf16_t* Du = Dg + (size_t)u * 16384; bf16_t* RTu = RTg + (size_t)u * 16384; bf16_t* QPu = QPg + (size_t)u * 8192; bf16_t* O0u = O0Tg + (size_t)u * 8192;
#pragma unroll 1
        for (int q = 0; q < 24; ++q) {
            const int idx = wid * 24 + q;
            f32x4 acc = (f32x4){0.f, 0.f, 0.f, 0.f};
            if (idx < 32) {
                const int dt = idx >> 2, it = idx & 3;
                acc = mma_nt(lds + GP_TT + (128 + dt * 16) * LD72, LD72, lds + GP_ATT + it * 16 * LD72, LD72, 2, fr, fq, acc);
                const int i = it * 16 + fr, d = dt * 16 + 4 * fq; const float eg = expf(sGC[i]);
                const u32x2 qv = *(const LAS u32x2*)(lds + GP_QS + i * LD136 + d * 2);
                u32x2 o; o.x = cvt_pk_bf16(bflo(qv.x) * eg - acc[0], bfhi(qv.x) * eg - acc[1]); o.y = cvt_pk_bf16(bflo(qv.y) * eg - acc[2], bfhi(qv.y) * eg - acc[3]);
                *(u32x2*)(QPu + i * 128 + d) = o;
            } else if (idx < 64) {
                const int it = (idx - 32) >> 3, nt = (idx - 32) & 7;
                acc = mma_nt(lds + GP_ATT + it * 16 * LD72, LD72, lds + GP_TT + nt * 16 * LD72, LD72, 2, fr, fq, acc);
                const int n = nt * 16 + fr, i = it * 16 + 4 * fq;
#ifdef DBG_O0PATTERN
                acc[0] = 0.01f * (float)((n + i) & 31); acc[1] = -acc[0]; acc[2] = 0.5f * acc[0]; acc[3] = 0.25f;
#endif
                u32x2 o; o.x = cvt_pk_bf16(acc[0], acc[1]); o.y = cvt_pk_bf16(acc[2], acc[3]);
                *(u32x2*)(O0u + n * 64 + i) = o;
            } else if (idx < 128) {
                const int kt = (idx - 64) >> 3, mt = (idx - 64) & 7;
                acc = mma_nt(lds + GP_TT + (128 + kt * 16) * LD72, LD72, lds + GP_KST + mt * 16 * LDKS, LDKS, 2, fr, fq, acc);
                const int m = mt * 16 + fr, k = kt * 16 + 4 * fq;
                u32x2 o; o.x = cvt_pk_bf16(acc[0], acc[1]); o.y = cvt_pk_bf16(acc[2], acc[3]);
                *(u32x2*)(Du + m * 128 + k) = o;
            } else {
                const int mt = (idx - 128) >> 3, nt = (idx - 128) & 7;
                acc = mma_nt(lds + GP_KST + mt * 16 * LDKS, LDKS, lds + GP_TT + nt * 16 * LD72, LD72, 2, fr, fq, acc);
                const int n = nt * 16 + fr, m = mt * 16 + 4 * fq;
                u32x2 o; o.x = cvt_pk_bf16(acc[0], acc[1]); o.y = cvt_pk_bf16(acc[2], acc[3]);
                *(u32x2*)(RTu + n * 128 + m) = o;
            }
        }
        if (tid == 0) EGL[u] = expf(gl);
    }
    __syncthreads();
}

struct ScanSet { bf16x8 d[2][4]; u32x2 r[2][2]; float egl; };
__device__ __forceinline__ void scan_load(ScanSet& R, const bf16_t* Dg, const bf16_t* RTg, const float* EGL, int u, unsigned offD, unsigned offR) {
    const bf16_t* Du = Dg + (size_t)u * 16384; const bf16_t* RTu = RTg + (size_t)u * 16384;
#pragma unroll
    for (int mt = 0; mt < 2; ++mt) {
#pragma unroll
        for (int kt = 0; kt < 4; ++kt) R.d[mt][kt] = *(const bf16x8*)(Du + offD + mt * 16 * 128 + kt * 32);
#pragma unroll
        for (int nt = 0; nt < 2; ++nt) R.r[mt][nt] = *(const u32x2*)(RTu + offR + nt * 16 * 128 + mt * 16);
    }
    R.egl = EGL[u];
}
__device__ __forceinline__ void scan_step(lp_t lds, int cur, const ScanSet& R, f32x4 (&acc)[2][2], bf16_t* SCg, int u, int cq, int rq, unsigned offS, int fr, int fq) {
    const lp_t img = lds + cur * 17408 + (32 * cq + fr) * LD136 + fq * 16, nimg = lds + (cur ^ 1) * 17408 + (32 * cq + fr) * LD136 + (32 * rq + 4 * fq) * 2;
    bf16_t* SCu = SCg + (size_t)u * 16384 + offS;
#pragma unroll
    for (int nt = 0; nt < 2; ++nt) {
        bf16x8 b[4];
#pragma unroll
        for (int kt = 0; kt < 4; ++kt) b[kt] = *(const LAS bf16x8*)(img + nt * 16 * LD136 + kt * 64);
        *(bf16x8*)(SCu + nt * 2048) = (rq == 0) ? b[0] : ((rq == 1) ? b[1] : ((rq == 2) ? b[2] : b[3]));
#pragma unroll
        for (int mt = 0; mt < 2; ++mt) {
            f32x4 t = (f32x4){0.f, 0.f, 0.f, 0.f};
#pragma unroll
            for (int kt = 0; kt < 4; ++kt) t = __builtin_amdgcn_mfma_f32_16x16x32_bf16(R.d[mt][kt], b[kt], t, 0, 0, 0);
            f32x4& a = acc[mt][nt]; const u32x2 r = R.r[mt][nt];
            a[0] = R.egl * a[0] + bflo(r.x) - t[0]; a[1] = R.egl * a[1] + bfhi(r.x) - t[1];
            a[2] = R.egl * a[2] + bflo(r.y) - t[2]; a[3] = R.egl * a[3] + bfhi(r.y) - t[3];
            u32x2 o; o.x = cvt_pk_bf16(a[0], a[1]); o.y = cvt_pk_bf16(a[2], a[3]);
            *(LAS u32x2*)(nimg + nt * 16 * LD136 + mt * 32) = o;
        }
        asm volatile("" ::: "memory");
    }
}
__device__ __forceinline__ void gdn_scan(lp_t lds, int bhh, const bf16_t* Dg, const bf16_t* RTg, const float* EGL, bf16_t* SCg) {
    int tid_ = threadIdx.x; asm volatile("" : "+v"(tid_));
    const int tid = tid_, wid = __builtin_amdgcn_readfirstlane(tid >> 6), lane = tid & 63, fr = lane & 15, fq = lane >> 4;
    const int bh = bhh >> 1, half = bhh & 1, cq = wid & 1, rq = wid >> 1, nb = half * 64 + 32 * cq, u0 = bh * NCH;
    unsigned offD = (unsigned)((32 * rq + fr) * 128 + 8 * fq), offR = (unsigned)((nb + fr) * 128 + 32 * rq + 4 * fq), offS = (unsigned)((nb + fr) * 128 + 32 * rq + 8 * fq);
    asm volatile("" : "+v"(offD), "+v"(offR), "+v"(offS));
    for (int i = tid; i < 2 * 17408 / 4; i += 512) ((LAS unsigned*)lds)[i] = 0u;
    f32x4 acc[2][2];
#pragma unroll
    for (int mt = 0; mt < 2; ++mt)
#pragma unroll
        for (int nt = 0; nt < 2; ++nt) acc[mt][nt] = (f32x4){0.f, 0.f, 0.f, 0.f};
    ScanSet R0, R1, R2;
    scan_load(R0, Dg, RTg, EGL, u0, offD, offR); scan_load(R1, Dg, RTg, EGL, u0 + 1, offD, offR);
    __syncthreads();
#define SCAN_CL(x) ((x) < NCH ? (x) : NCH - 1)
    int c = 0;
#pragma unroll 1
    for (; c + 2 < NCH; c += 3) {
        scan_load(R2, Dg, RTg, EGL, u0 + SCAN_CL(c + 2), offD, offR); scan_step(lds, c & 1, R0, acc, SCg, u0 + c, cq, rq, offS, fr, fq); __syncthreads();
        scan_load(R0, Dg, RTg, EGL, u0 + SCAN_CL(c + 3), offD, offR); scan_step(lds, (c + 1) & 1, R1, acc, SCg, u0 + c + 1, cq, rq, offS, fr, fq); __syncthreads();
        scan_load(R1, Dg, RTg, EGL, u0 + SCAN_CL(c + 4), offD, offR); scan_step(lds, c & 1, R2, acc, SCg, u0 + c + 2, cq, rq, offS, fr, fq); __syncthreads();
    }
    scan_step(lds, c & 1, R0, acc, SCg, u0 + c, cq, rq, offS, fr, fq); __syncthreads();
    scan_step(lds, (c + 1) & 1, R1, acc, SCg, u0 + c + 1, cq, rq, offS, fr, fq); __syncthreads();
#undef SCAN_CL
}

__device__ __forceinline__ void gdn_out_pair(int pairidx, const bf16_t* QPg, const bf16_t* O0Tg, const bf16_t* SCg, const bf16_t* Z, const float* gnw, bf16_t* YCAT) {
    int tid_ = threadIdx.x; asm volatile("" : "+v"(tid_));
    const int tid = tid_, wid = __builtin_amdgcn_readfirstlane(tid >> 6), lane = tid & 63, fr = lane & 15, fq = lane >> 4;
    const int u = pairidx * 2 + (wid >> 2), mt = wid & 3;
    const int b = u >> 9, h = (u >> 7) & 3, c = u & 127;
    const bf16_t* QPu = QPg + (size_t)u * 8192; const bf16_t* O0u = O0Tg + (size_t)u * 8192; const bf16_t* SCu = SCg + (size_t)u * 16384;
    bf16x8 a[4];
#pragma unroll
    for (int kt = 0; kt < 4; ++kt) a[kt] = *(const bf16x8*)(QPu + (16 * mt + fr) * 128 + 32 * kt + 8 * fq);
    f32x4 acc[8]; float ss[4] = {0.f, 0.f, 0.f, 0.f};
#pragma unroll
    for (int nt = 0; nt < 8; ++nt) {
        const u32x2 o0 = *(const u32x2*)(O0u + (16 * nt + fr) * 64 + 16 * mt + 4 * fq);
        acc[nt] = (f32x4){bflo(o0.x), bfhi(o0.x), bflo(o0.y), bfhi(o0.y)};
#ifndef DBG_NO_STATE
#pragma unroll
        for (int kt = 0; kt < 4; ++kt) { const bf16x8 bb = *(const bf16x8*)(SCu + (16 * nt + fr) * 128 + 32 * kt + 8 * fq); acc[nt] = __builtin_amdgcn_mfma_f32_16x16x32_bf16(a[kt], bb, acc[nt], 0, 0, 0); }
#endif
#pragma unroll
        for (int j = 0; j < 4; ++j) ss[j] += acc[nt][j] * acc[nt][j];
    }
#pragma unroll
    for (int j = 0; j < 4; ++j) { float s = ss[j]; s += __shfl_xor(s, 1); s += __shfl_xor(s, 2); s += __shfl_xor(s, 4); s += __shfl_xor(s, 8); ss[j] = rsqrtf(s * (1.0f / HD) + EPS); }
    const size_t row0 = (size_t)b * SEQ + (size_t)c * CH + 16 * mt + 4 * fq;
#pragma unroll
    for (int nt = 0; nt < 8; ++nt) { const int n = 16 * nt + fr; const float w = gnw[n];
#pragma unroll
        for (int j = 0; j < 4; ++j) { const float z = bf2f(Z[(row0 + j) * 512 + h * 128 + n]); float ov = acc[nt][j] * ss[j] * w * siluf_(z);
#ifdef DBG_GDN_ZERO
            ov = 0.f;
#endif
#ifdef DBG_ZONLY
            ov = siluf_(z) * w;
#endif
#ifdef DBG_O0ONLY
            ov = acc[nt][j];
#endif
#ifdef DBG_SANITIZE
            if (!(fabsf(ov) < 1e30f)) ov = 0.f;
#endif
            YCAT[(row0 + j) * DM + h * 128 + n] = f2bf(ov); } }
}

struct S5Par { float are, aim, bbr[16], bbi[16]; };
__device__ __forceinline__ void s5_params(S5Par& P, int g, int p, const float* a_re, const float* a_im, const float* log_dt, const float* b_re, const float* b_im) {
    const float ar = fminf(a_re[g * 64 + p], -1e-4f), ai = a_im[g * 64 + p], dt = expf(log_dt[g]);
    const float mag = expf(dt * ar); P.are = mag * cosf(dt * ai); P.aim = mag * sinf(dt * ai);
    const float den = ar * ar + ai * ai, zr = P.are - 1.0f, zi = P.aim, f_r = (zr * ar + zi * ai) / den, f_i = (zi * ar - zr * ai) / den;
#pragma unroll
    for (int q = 0; q < 4; ++q) { const f32x4 br = *(const f32x4*)(b_re + (size_t)(g * 64 + p) * 16 + 4 * q), bi = *(const f32x4*)(b_im + (size_t)(g * 64 + p) * 16 + 4 * q);
#pragma unroll
        for (int e = 0; e < 4; ++e) { P.bbr[4 * q + e] = f_r * br[e] - f_i * bi[e]; P.bbi[4 * q + e] = f_r * bi[e] + f_i * br[e]; } }
}
__device__ __forceinline__ void s5_load_u(LAS float* su, const bf16_t* U, size_t row, int g, int lane) {
    const bf16_t* src = U + (row + lane) * 512 + g * 16; const u32x4 x0 = *(const u32x4*)src, x1 = *(const u32x4*)(src + 8);
    LAS f32x4* d = (LAS f32x4*)(su + lane * 16);
    d[0] = (f32x4){bflo(x0.x), bfhi(x0.x), bflo(x0.y), bfhi(x0.y)}; d[1] = (f32x4){bflo(x0.z), bfhi(x0.z), bflo(x0.w), bfhi(x0.w)};
    d[2] = (f32x4){bflo(x1.x), bfhi(x1.x), bflo(x1.y), bfhi(x1.y)}; d[3] = (f32x4){bflo(x1.z), bfhi(x1.z), bflo(x1.w), bfhi(x1.w)};
}
__device__ __forceinline__ void s5_step(const S5Par& P, const LAS float* su, int t, float& xr, float& xi) {
    const LAS f32x4* uu = (const LAS f32x4*)(su + t * 16); float br = 0.f, bi = 0.f;
#pragma unroll
    for (int q = 0; q < 4; ++q) { const f32x4 v = uu[q];
#pragma unroll
        for (int e = 0; e < 4; ++e) { br += P.bbr[4 * q + e] * v[e]; bi += P.bbi[4 * q + e] * v[e]; } }
    const float nr = P.are * xr - P.aim * xi + br, ni = P.are * xi + P.aim * xr + bi; xr = nr; xi = ni;
}
__device__ __forceinline__ void s5_pass_a(lp_t wlds, int v, const bf16_t* U, float* E, const float* a_re, const float* a_im, const float* log_dt, const float* b_re, const float* b_im, int lane) {
    asm volatile("" : "+v"(lane));
    const int seg = v & (NSEG - 1), g = (v >> 5) & 31, b = v >> 10;
    S5Par P; s5_params(P, g, lane, a_re, a_im, log_dt, b_re, b_im);
    LAS float* su = (LAS float*)wlds; float xr = 0.f, xi = 0.f;
    const size_t row0 = (size_t)b * SEQ + (size_t)seg * LSEG;
#pragma unroll 1
    for (int tile = 0; tile < LSEG / 64; ++tile) {
        s5_load_u(su, U, row0 + tile * 64, g, lane);
        LDS_WAIT(); asm volatile("" ::: "memory");
#pragma unroll 4
        for (int t = 0; t < 64; ++t) s5_step(P, su, t, xr, xi);
        LDS_WAIT(); asm volatile("" ::: "memory");
    }
    *(f32x2*)(E + ((size_t)v * 64 + lane) * 2) = (f32x2){xr, xi};
}
__device__ __forceinline__ void s5_pass_b(lp_t wlds, int v, const bf16_t* U, const float* E, const float* a_re, const float* a_im, const float* log_dt, const float* b_re, const float* b_im,
                                          const float* c_re, const float* c_im, const float* dvec, bf16_t* YS, int lane) {
    asm volatile("" : "+v"(lane));
    const int seg = v & (NSEG - 1), g = (v >> 5) & 31, b = v >> 10, fr = lane & 15, fq = lane >> 4;
    S5Par P; s5_params(P, g, lane, a_re, a_im, log_dt, b_re, b_im);
    float pr = P.are, pi = P.aim;
#pragma unroll
    for (int s = 0; s < 8; ++s) { const float nr = pr * pr - pi * pi, ni = 2.0f * pr * pi; pr = nr; pi = ni; }
    float xr = 0.f, xi = 0.f;
    for (int s = 0; s < seg; ++s) { const f32x2 e = *(const f32x2*)(E + ((size_t)(v - seg + s) * 64 + lane) * 2); const float nr = pr * xr - pi * xi + e[0], ni = pr * xi + pi * xr + e[1]; xr = nr; xi = ni; }
    bf16x8 cb[4];
#pragma unroll
    for (int kt = 0; kt < 4; ++kt) { const float* src = (kt < 2 ? c_re : c_im) + (size_t)(g * 16 + fr) * 64 + 32 * (kt & 1) + 8 * fq; const float sg = kt < 2 ? 1.f : -1.f;
        const f32x4 v0 = *(const f32x4*)src, v1 = *(const f32x4*)(src + 4); u32x4 w; w.x = cvt_pk_bf16(sg * v0[0], sg * v0[1]); w.y = cvt_pk_bf16(sg * v0[2], sg * v0[3]); w.z = cvt_pk_bf16(sg * v1[0], sg * v1[1]); w.w = cvt_pk_bf16(sg * v1[2], sg * v1[3]);
        cb[kt] = __builtin_bit_cast(bf16x8, w); }
    const float dco = dvec[g * 16 + fr];
    LAS float* su = (LAS float*)wlds; const lp_t xt = wlds + 4096;
    const size_t row0 = (size_t)b * SEQ + (size_t)seg * LSEG;
#pragma unroll 1
    for (int tile = 0; tile < LSEG / 64; ++tile) {
        s5_load_u(su, U, row0 + tile * 64, g, lane);
        LDS_WAIT(); asm volatile("" ::: "memory");
#pragma unroll 1
        for (int sub = 0; sub < 4; ++sub) {
#pragma unroll 4
            for (int tt = 0; tt < 16; ++tt) { s5_step(P, su, sub * 16 + tt, xr, xi);
                *(LAS unsigned short*)(xt + tt * LD136 + lane * 2) = f2bf(xr); *(LAS unsigned short*)(xt + tt * LD136 + (64 + lane) * 2) = f2bf(xi); }
            LDS_WAIT(); asm volatile("" ::: "memory");
            f32x4 acc = (f32x4){0.f, 0.f, 0.f, 0.f};
#pragma unroll
            for (int kt = 0; kt < 4; ++kt) { const bf16x8 a = *(const LAS bf16x8*)(xt + fr * LD136 + (32 * kt + 8 * fq) * 2); acc = __builtin_amdgcn_mfma_f32_16x16x32_bf16(a, cb[kt], acc, 0, 0, 0); }
#pragma unroll
            for (int j = 0; j < 4; ++j) { const int t = sub * 16 + 4 * fq + j; const float y = acc[j] + dco * su[t * 16 + fr];
                YS[(row0 + tile * 64 + t) * 512 + g * 16 + fr] = f2bf(gelu_tanh(y)); }
            LDS_WAIT(); asm volatile("" ::: "memory");
        }
    }
}


#define XB_TMO      128
#define XB_XCNT(j)  (256  + 64 * (j))
#define XB_XSUB(j)  (1280 + 64 * (j))
#define XB_XGEN(j)  (2304 + 64 * (j))
#define XB_TOP      3328
#define XB_TOPGEN   3392
#define XCD_BAR_WORDS 3456
#define XB_SPIN_CAP (1u << 22)
__device__ __forceinline__ unsigned xb_ld(unsigned* p)              { return __hip_atomic_load(p, __ATOMIC_RELAXED, __HIP_MEMORY_SCOPE_AGENT); }
__device__ __forceinline__ unsigned xb_add(unsigned* p, unsigned v) { return __hip_atomic_fetch_add(p, v, __ATOMIC_RELAXED, __HIP_MEMORY_SCOPE_AGENT); }
__device__ __forceinline__ unsigned xb_xcc_id() { return (unsigned)__builtin_amdgcn_s_getreg((3 << 11) | 20) & 0xFu; }
#define XB_SPIN(cond, bar) do { unsigned _sp = 0; while (cond) { __builtin_amdgcn_s_sleep(1); \
    if ((++_sp & 255u) == 0u) { if (xb_ld(&(bar)[XB_TMO])) break; if (_sp > XB_SPIN_CAP) { atomicAdd(&(bar)[XB_TMO], 1u); break; } } } } while (0)
struct XcdBarrier { unsigned* bar; unsigned x; volatile LAS unsigned* st; };
__device__ __forceinline__ XcdBarrier xcd_barrier_post(unsigned* bar, volatile LAS unsigned* st) {
    XcdBarrier b; b.bar = bar; b.x = xb_xcc_id(); b.st = st;
    if (threadIdx.x == 0) (void)xb_add(&bar[XB_XCNT(b.x)], 1u);
    return b;
}
__device__ __forceinline__ void xcd_barrier_complete(unsigned* bar, unsigned x, unsigned& nloc, unsigned& nx) {
    const unsigned G = gridDim.x * gridDim.y * gridDim.z;
    unsigned sum, cnt, mine, sp = 0u;
    for (;;) {
        sum = 0u; cnt = 0u; mine = 0u;
#pragma unroll
        for (unsigned j = 0; j < 16; ++j) { const unsigned c = xb_ld(&bar[XB_XCNT(j)]); sum += c; cnt += (c > 0u) ? 1u : 0u; mine = (j == x) ? c : mine; }
        if (sum == G) break;
        __builtin_amdgcn_s_sleep(1);
        if ((++sp & 255u) == 0u) { if (xb_ld(&bar[XB_TMO])) break; if (sp > XB_SPIN_CAP) { atomicAdd(&bar[XB_TMO], 1u); break; } }
    }
    nloc = mine > 0u ? mine : 1u; nx = cnt > 0u ? cnt : 1u;
}
__device__ __forceinline__ void xcd_barrier(const XcdBarrier& b) {
    asm volatile("s_waitcnt vmcnt(0) lgkmcnt(0)" ::: "memory");
    __syncthreads();
    if (threadIdx.x == 0) {
        unsigned* bar = b.bar;
        __builtin_amdgcn_s_waitcnt(0);
        unsigned nloc = b.st[0], nx = b.st[1];
        if (nloc == 0u) { xcd_barrier_complete(bar, b.x, nloc, nx); b.st[0] = nloc; b.st[1] = nx; }
        const unsigned old = xb_add(&bar[XB_XSUB(b.x)], 1u);
        const unsigned gen = old / nloc;
        if (old + 1u == (gen + 1u) * nloc) {
            __builtin_amdgcn_fence(__ATOMIC_RELEASE, "agent");
            asm volatile("s_waitcnt vmcnt(0)" ::: "memory");
            const unsigned og = xb_add(&bar[XB_TOP], 1u);
            const unsigned tg = og / nx;
            if (og + 1u == (tg + 1u) * nx) xb_add(&bar[XB_TOPGEN], 1u);
            else XB_SPIN(xb_ld(&bar[XB_TOPGEN]) == tg, bar);
            __builtin_amdgcn_fence(__ATOMIC_ACQUIRE, "agent");
            xb_add(&bar[XB_XGEN(b.x)], 1u);
            asm volatile("s_waitcnt vmcnt(0)" ::: "memory");
        } else {
            XB_SPIN(xb_ld(&bar[XB_XGEN(b.x)]) == gen, bar);
            __builtin_amdgcn_fence(__ATOMIC_ACQUIRE, "agent");
            asm volatile("s_waitcnt vmcnt(0)" ::: "memory");
        }
    }
    __syncthreads();
}

__global__ void __launch_bounds__(512, 2) hybrid_fwd(Args args) {
    extern __shared__ __attribute__((aligned(16))) unsigned char lds_raw[];
    cg::grid_group grid = cg::this_grid();
    const lp_t lds = (lp_t)lds_raw;
    const int tid = threadIdx.x, lane = tid & 63, wave = __builtin_amdgcn_readfirstlane(tid >> 6);
    const int G = gridDim.x, bx = blockIdx.x, gw = bx * 8 + wave, NGW = G * 8;
    typedef const __attribute__((address_space(4))) Args* kargp_t;
    const kargp_t kp0 = (kargp_t)__builtin_amdgcn_kernarg_segment_ptr();
#define ARGS() ({ kargp_t p_ = kp0; asm volatile("" : "+s"(p_)); p_; })
    unsigned char* ws = ARGS()->ws;
    float* MOD = (float*)(ws + WS_MOD); float* PART = (float*)(ws + WS_PART);
    bf16_t* H = (bf16_t*)(ws + WS_H); bf16_t* HID = (bf16_t*)(ws + WS_BIG); bf16_t* YR = (bf16_t*)(ws + WS_YR);
    {
        if (tid < 16) ((LAS unsigned*)(lds + LDS_BYTES - 64))[tid] = 0u;
        __syncthreads();
    }
    XcdBarrier xbar = xcd_barrier_post((unsigned*)(ws + WS_CTL), (volatile LAS unsigned*)(lds + LDS_BYTES - 64));
    grid.sync();
#define GSYNC() xcd_barrier(xbar)

    {
        LAS float* scr = (LAS float*)(lds + wave * 8704);
        constexpr int I_FFI = 16 * 176, I_FFO = 44 * 32, I_MXI = 16 * 88, I_GLU = 8 * 16, I_MXO = 16 * 32;
        constexpr int I_LAYER = 2 * I_FFI + 2 * I_FFO + I_MXI + I_GLU + I_MXO;
        for (int it = gw; it < DEPTH * I_LAYER; it += NGW) {
            const int l = it / I_LAYER; int r = it % I_LAYER; bf16_t* wl = (bf16_t*)(ws + WS_W + (size_t)l * W_LAYER);
            if (r < I_FFI) { transpose_item(ARGS()->in[6] + (size_t)l * DM * 2 * DFF, DM, 2 * DFF, (bf16_t*)((char*)wl + WO_FF1_IN), scr, r / 176, r % 176, 1, lane); continue; } r -= I_FFI;
            if (r < I_FFO) { transpose_item(ARGS()->in[7] + (size_t)l * DFF * DM, DFF, DM, (bf16_t*)((char*)wl + WO_FF1_OUT), scr, r / 32, r % 32, 0, lane); continue; } r -= I_FFO;
            if (r < I_MXI) { transpose_item(ARGS()->in[10] + (size_t)l * DM * PROJ_W, DM, PROJ_W, (bf16_t*)((char*)wl + WO_MIX_IN), scr, r / 88, r % 88, 2, lane); continue; } r -= I_MXI;
            if (r < I_GLU) { transpose_item(ARGS()->in[23] + (size_t)l * 512 * 512, 512, 512, (bf16_t*)((char*)wl + WO_GLU), scr, r / 16, r % 16, 0, lane); continue; } r -= I_GLU;
            if (r < I_MXO) { transpose_item(ARGS()->in[24] + (size_t)l * DM * DM, DM, DM, (bf16_t*)((char*)wl + WO_MIX_OUT), scr, r / 32, r % 32, 0, lane); continue; } r -= I_MXO;
            if (r < I_FFI) { transpose_item(ARGS()->in[27] + (size_t)l * DM * 2 * DFF, DM, 2 * DFF, (bf16_t*)((char*)wl + WO_FF2_IN), scr, r / 176, r % 176, 1, lane); continue; } r -= I_FFI;
            transpose_item(ARGS()->in[28] + (size_t)l * DFF * DM, DFF, DM, (bf16_t*)((char*)wl + WO_FF2_OUT), scr, r / 32, r % 32, 0, lane);
        }
        __syncthreads();
        LAS float* ca = (LAS float*)lds; LAS float* red = (LAS float*)(lds + 16384);
        for (int i = tid; i < NB * DM; i += 512) { const float v = ARGS()->in[1][i]; ca[i] = v / (1.0f + expf(-v)); }
        __syncthreads();
        for (int it = bx; it < DEPTH * (NMOD / 64); it += G) {
            const int l = it / (NMOD / 64), cb = it % (NMOD / 64), col = cb * 64 + lane;
            const float* wm = ARGS()->in[2] + (size_t)l * DM * NMOD + col;
            float a0 = 0.f, a1 = 0.f, a2 = 0.f, a3 = 0.f;
#pragma unroll 8
            for (int k = wave * 128; k < wave * 128 + 128; ++k) { const float w = wm[(size_t)k * NMOD]; a0 += ca[k] * w; a1 += ca[DM + k] * w; a2 += ca[2 * DM + k] * w; a3 += ca[3 * DM + k] * w; }
            red[(wave * 4 + 0) * 64 + lane] = a0; red[(wave * 4 + 1) * 64 + lane] = a1; red[(wave * 4 + 2) * 64 + lane] = a2; red[(wave * 4 + 3) * 64 + lane] = a3;
            __syncthreads();
            if (tid < 256) { const int b = tid >> 6; float s = ARGS()->in[3][(size_t)l * NMOD + col];
#pragma unroll
                for (int w = 0; w < 8; ++w) s += red[(w * 4 + b) * 64 + lane];
                MOD[((size_t)l * NB + b) * NMOD + col] = s; }
            __syncthreads();
        }
    }
    GSYNC();
    finalize_phase(ARGS()->in[0], nullptr, nullptr, nullptr, nullptr, 0.f, nullptr, ARGS()->in[4], MOD + 0 * DM, MOD + 1 * DM, H, gw, NGW, lane);
    GSYNC();

#pragma unroll 1
    for (int l = 0; l < DEPTH; ++l) {
        const unsigned char* wl = ws + WS_W + (size_t)l * W_LAYER;
        const float* modl = MOD + (size_t)l * NB * NMOD;
#pragma unroll 1
        for (int sub = 0; sub < 3; ++sub) {
#ifdef SKIP_MIX
            if (sub == 1) continue;
#endif
            if (sub != 1) {
                { pg8::Gemm g{H, (const bf16_t*)(wl + (sub == 0 ? WO_FF1_IN : WO_FF2_IN)), M, 2 * DFF, DM, DM, DM}; pg8::StaticOrder S; S.init(M, 2 * DFF, G, bx);
                  EpiSwiglu E{HID, DFF};
#pragma unroll 1
                  for (int rep = 0; rep < ARGS()->rep_a; ++rep) { pg8::gemm_phase<EpiSwiglu, true>(lds, g, S, E); __syncthreads(); }
 }
                GSYNC();
                { pg8::Gemm g{HID, (const bf16_t*)(wl + (sub == 0 ? WO_FF1_OUT : WO_FF2_OUT)), M, DM, DFF, DFF, DFF}; pg8::StaticOrder S; S.init(M, DM, G, bx);
                  EpiYraw E{YR, PART};
#pragma unroll 1
                  for (int rep = 0; rep < ARGS()->rep_a; ++rep) { pg8::gemm_phase<EpiYraw, true>(lds, g, S, E); __syncthreads(); }
 }
                GSYNC();
            } else {
                bf16_t* QKV = (bf16_t*)(ws + WS_QKV); bf16_t* Zb = (bf16_t*)(ws + WS_Z); bf16_t* Ub = (bf16_t*)(ws + WS_U);
                float* BETA = (float*)(ws + WS_BETA); float* Gg = (float*)(ws + WS_G); float* EGL = (float*)(ws + WS_EGL); float* S5E = (float*)(ws + WS_S5E);
                bf16_t* Dg = (bf16_t*)(ws + WS_D); bf16_t* RTg = (bf16_t*)(ws + WS_RT); bf16_t* QPg = (bf16_t*)(ws + WS_QP); bf16_t* O0Tg = (bf16_t*)(ws + WS_O0T);
                bf16_t* SCg = (bf16_t*)(ws + WS_SC); bf16_t* YS = (bf16_t*)(ws + WS_YS); bf16_t* YCAT = (bf16_t*)(ws + WS_YCAT);
                { pg8::Gemm g{H, (const bf16_t*)(wl + WO_MIX_IN), M, MIXN, DM, DM, DM}; pg8::StaticOrder S; S.init(M, MIXN, G, bx);
                  EpiInproj E{QKV, Zb, Ub, BETA, Gg, ARGS()->in[12] + l * 4, ARGS()->in[13] + l * 4};
#ifndef SKIP_GI1
pg8::gemm_phase<EpiInproj, true>(lds, g, S, E);
#endif
 }
                GSYNC();

#pragma unroll 1
                for (int rep = 0; rep < ARGS()->rep_b; ++rep)
                for (int u = bx; u < NUNIT; u += G) gdn_pre_unit(lds, u, QKV, ARGS()->in[11] + (size_t)l * 4 * 1536, BETA, Gg, Dg, RTg, QPg, O0Tg, EGL);

                __syncthreads();

#ifndef SKIP_S5A
                for (int v = gw; v < NB * S5G * NSEG; v += NGW)
                    s5_pass_a(lds + wave * 8704, v, Ub, S5E, ARGS()->in[15] + l * 2048, ARGS()->in[16] + l * 2048, ARGS()->in[17] + l * 32, ARGS()->in[18] + (size_t)l * 32768, ARGS()->in[19] + (size_t)l * 32768, lane);
#endif

                GSYNC();

#pragma unroll 1
                for (int rep = 0; rep < ARGS()->rep_b; ++rep) {
                if (bx < 32) gdn_scan(lds, bx, Dg, RTg, EGL, SCg);


#ifndef SKIP_S5B
                if (bx >= 32) for (int v = (bx - 32) * 8 + wave; v < NB * S5G * NSEG; v += (G - 32) * 8)
                    s5_pass_b(lds + wave * 8704, v, Ub, S5E, ARGS()->in[15] + l * 2048, ARGS()->in[16] + l * 2048, ARGS()->in[17] + l * 32, ARGS()->in[18] + (size_t)l * 32768, ARGS()->in[19] + (size_t)l * 32768,
                              ARGS()->in[20] + (size_t)l * 32768, ARGS()->in[21] + (size_t)l * 32768, ARGS()->in[22] + l * 512, YS, lane);
#endif
                }

                GSYNC();

#ifndef SKIP_OUT
                for (int p = bx; p < NUNIT / 2; p += G) gdn_out_pair(p, QPg, O0Tg, SCg, Zb, ARGS()->in[14] + l * HD, YCAT);
#endif

                { pg8::Gemm g{YS, (const bf16_t*)(wl + WO_GLU), M, 512, 512, 512, 512}; pg8::StaticOrder S; S.init(M, 512, G, bx);
                  EpiGlu E{YS, YCAT};
#ifndef SKIP_GG1
pg8::gemm_phase<EpiGlu, true>(lds, g, S, E);
#endif
 }
                GSYNC();
                { pg8::Gemm g{YCAT, (const bf16_t*)(wl + WO_MIX_OUT), M, DM, DM, DM, DM}; pg8::StaticOrder S; S.init(M, DM, G, bx);
                  EpiYraw E{YR, PART};
#ifndef SKIP_GY2
pg8::gemm_phase<EpiYraw, true>(lds, g, S, E);
#endif
 }
                GSYNC();
            }
            {
                const float* xsrc = (l == 0 && sub == 0) ? ARGS()->in[0] : ARGS()->out;
                const float* wpost = (sub == 0 ? ARGS()->in[5] : (sub == 1 ? ARGS()->in[9] : ARGS()->in[26])) + l * DM;
                const float* gate = modl + (3 * sub + 2) * DM; const float gs = sub == 1 ? 1.0f : 0.5f;
                const bool last = (l == DEPTH - 1 && sub == 2);
                const int nl = sub == 2 ? l + 1 : l, nsub = sub == 2 ? 0 : sub + 1;
                const float* wpre = last ? nullptr : (nsub == 0 ? ARGS()->in[4] : (nsub == 1 ? ARGS()->in[8] : ARGS()->in[25])) + nl * DM;
                const float* modn = MOD + (size_t)(last ? 0 : nl) * NB * NMOD;
                finalize_phase(xsrc, ARGS()->out, YR, PART, gate, gs, wpost, wpre, modn + (3 * nsub) * DM, modn + (3 * nsub + 1) * DM, last ? nullptr : H, gw, NGW, lane);
            }
            GSYNC();
        }
    }
}

extern "C" void kernel_launch(void* const* d_in, const int* in_sizes, int n_in, void* d_out, int out_size, void* d_ws, size_t ws_size, hipStream_t stream) {
    static int grid = 0;
    if (grid == 0) {
        if (n_in != 29 || ws_size < WS_END) { fprintf(stderr, "kernel_launch: unexpected n_in %d or ws %zu\n", n_in, ws_size); grid = -1; return; }
        int dev = 0, cus = 0, per_cu = 0;
        hipGetDevice(&dev); hipDeviceGetAttribute(&cus, hipDeviceAttributeMultiprocessorCount, dev);
        hipFuncSetAttribute((const void*)hybrid_fwd, hipFuncAttributeMaxDynamicSharedMemorySize, LDS_BYTES);
        hipOccupancyMaxActiveBlocksPerMultiprocessor(&per_cu, (const void*)hybrid_fwd, 512, LDS_BYTES);
        if (per_cu < 1) { fprintf(stderr, "kernel_launch: occupancy query says %d blocks per CU\n", per_cu); per_cu = 1; }
        (void)hipGetLastError();
        grid = cus * 1;
    }
    if (grid < 0) return;
    if (hipMemsetAsync((char*)d_ws + WS_CTL, 0, CTL_BYTES, stream) != hipSuccess) { fprintf(stderr, "memset failed\n"); return; }
    Args a{};
    for (int i = 0; i < 29; ++i) a.in[i] = (const float*)d_in[i];
    a.out = (float*)d_out; a.ws = (unsigned char*)d_ws; a.rep_a = REP_A; a.rep_b = REP_B;
    void* kargs[] = {&a};
    hipError_t e = hipLaunchCooperativeKernel((const void*)hybrid_fwd, dim3(grid), dim3(512), kargs, LDS_BYTES, stream);
    if (e != hipSuccess) fprintf(stderr, "cooperative launch failed: %s (grid %d)\n", hipGetErrorString(e), grid);
}
```

```cpp
#include <hip/hip_runtime.h>
#include <hip/hip_cooperative_groups.h>
#include <cstdio>
#include <cstdint>
namespace cg = cooperative_groups;

#define LAS __attribute__((address_space(3)))
typedef unsigned short bf16_t;
typedef short bf16x8 __attribute__((ext_vector_type(8)));
typedef float f32x4 __attribute__((ext_vector_type(4)));
typedef float f32x2 __attribute__((ext_vector_type(2)));
typedef unsigned u32x4 __attribute__((ext_vector_type(4)));
typedef unsigned u32x2 __attribute__((ext_vector_type(2)));
typedef LAS unsigned char* lp_t;

constexpr int DM = 1024, NB = 4, SEQ = 8192, M = NB * SEQ, DEPTH = 2;
constexpr int DFF = 2816, NH = 4, HD = 128, CH = 64, NCH = SEQ / CH;
constexpr int NUNIT = NB * NH * NCH;
constexpr int S5G = 32, S5P = 64, S5H = 16, LSEG = 256, NSEG = SEQ / LSEG;
constexpr int NMOD = 9 * DM;
constexpr int PROJ_W = 2568, MIXN = 2816;
constexpr float EPS = 1e-6f;

namespace pg8 {
constexpr int BM = 256, BK = 64, HALF = 128, HTB = HALF * BK * 2, STAGE_BYTES = 8 * HTB, NXCD = 8, WGM = 8;
__device__ __forceinline__ int lds_byte(int r, int c) { const int st = (r >> 4) * 2 + (c >> 5), rr = r & 15, cc = c & 31, ob = rr * 64 + cc * 2; return st * 1024 + (ob ^ (((ob >> 9) & 1) << 5)); }
__device__ __forceinline__ void stage_rc(int b, int& R, int& C) { const int st = b / 1024, sb = b % 1024, swz = sb ^ (((sb >> 9) & 1) << 5); R = (st >> 1) * 16 + swz / 64; C = (st & 1) * 32 + (swz % 64) / 2; }
__device__ __forceinline__ int perm32(int rho) { const int n = rho >> 4, i = rho & 15; return 8 * (i >> 2) + 4 * n + (i & 3); }
struct Unit { int pm, pn; };
struct Gemm { const bf16_t* A; const bf16_t* Bt; int M, N, K, lda, ldb; };
struct StaticOrder {
    int nM, nN, nwg, G, c;
    __device__ void init(int M_, int N_, int G_, int c_) { nM = M_ / BM; nN = N_ / BM; nwg = nM * nN; G = G_; c = c_; }
    __device__ bool next(int i, Unit& u) const {
        const long L = (long)i * G + c; if (L >= nwg) return false;
        int wgid = (int)L; { const int q = nwg / NXCD, r = nwg % NXCD, xcd = wgid % NXCD, off = wgid / NXCD; wgid = (xcd < r ? xcd * (q + 1) : r * (q + 1) + (xcd - r) * q) + off; }
        const int nig = WGM * nN, gid = wgid / nig, fm = gid * WGM, gsz = (nM - fm) < WGM ? (nM - fm) : WGM;
        u.pm = fm + ((wgid % nig) % gsz); u.pn = (wgid % nig) / gsz; return true;
    }
};
typedef __bf16 bf16x2_t __attribute__((ext_vector_type(2)));
__device__ __forceinline__ unsigned cvt_pk_bf16(float lo, float hi) { f32x2 v = {lo, hi}; bf16x2_t b = __builtin_convertvector(v, bf16x2_t); return __builtin_bit_cast(unsigned, b); }

template <class Epi, bool ALIGN_EPI>
__device__ __forceinline__ void gemm_phase(lp_t lds, const Gemm g, const StaticOrder& S, const Epi& E) {
    int tid_ = threadIdx.x; asm volatile("" : "+v"(tid_));
    const int tid = tid_, wid = __builtin_amdgcn_readfirstlane(tid >> 6), lane = tid & 63, wr = wid >> 2, wc = wid & 3, fr = lane & 15, fq = lane >> 4;
    const int K = g.K, nt = K / BK;
    unsigned voffA[2], voffB[2];
#pragma unroll
    for (int i = 0; i < 2; ++i) { int R, C; stage_rc(tid * 16 + i * 8192, R, C); const int Rb = Epi::PERM ? ((R & ~31) + perm32(R & 31)) : R;
        voffA[i] = (unsigned)(R * g.lda + C) * 2u; voffB[i] = (unsigned)(Rb * g.ldb + C) * 2u; }
    const size_t kstep = (size_t)(BK * 2);
    const size_t hsA = (size_t)HALF * g.lda * 2, hsB = (size_t)HALF * g.ldb * 2, tsA = 2 * hsA, tsB = 2 * hsB;
    const unsigned ldsw = (unsigned)wid * 1024u;
    const int aoff = lds_byte(wr * 64 + fr, fq * 8), boff = lds_byte(wc * 32 + fr, fq * 8);
#define PG8_SA(b, h) (((b) * 2 + (h)) * HTB)
#define PG8_SB(b, h) ((4 + (b) * 2 + (h)) * HTB)
#define PG8_STAGE(bufoff, gbase, voff) do { _Pragma("unroll") for (int _i = 0; _i < 2; ++_i) \
        __builtin_amdgcn_global_load_lds((const unsigned*)((const char*)(gbase) + (voff)[_i]), (LAS unsigned*)(lds + (bufoff) + ldsw + _i * 8192), 16, 0, 0); } while (0)
#define PG8_LDA(dst, b, h) do { _Pragma("unroll") for (int m = 0; m < 4; ++m) _Pragma("unroll") for (int k = 0; k < 2; ++k) dst[m][k] = *(const LAS bf16x8*)(lds + PG8_SA(b, h) + aoff + m * 2048 + k * 1024); } while (0)
#define PG8_LDB(dst, b, h) do { _Pragma("unroll") for (int n = 0; n < 2; ++n) _Pragma("unroll") for (int k = 0; k < 2; ++k) dst[n][k] = *(const LAS bf16x8*)(lds + PG8_SB(b, h) + boff + n * 2048 + k * 1024); } while (0)
#define PG8_MMA(ai, bj, At, Bt) do { __builtin_amdgcn_s_setprio(1); _Pragma("unroll") for (int m = 0; m < 4; ++m) _Pragma("unroll") for (int n = 0; n < 2; ++n) _Pragma("unroll") for (int k = 0; k < 2; ++k) \
        acc[ai][bj][m][n] = __builtin_amdgcn_mfma_f32_16x16x32_bf16(Bt[n][k], At[m][k], acc[ai][bj][m][n], 0, 0, 0); __builtin_amdgcn_s_setprio(0); } while (0)
#define PG8_WAIT_V(n) asm volatile("s_waitcnt vmcnt(" #n ")" ::: "memory")
#define PG8_WAIT_L(n) asm volatile("s_waitcnt lgkmcnt(" #n ")" ::: "memory")
#define PG8_BAR __builtin_amdgcn_s_barrier()
#define PG8_SCHED __builtin_amdgcn_sched_barrier(0)
    Unit cur, nxt; int ui = 0;
    if (!S.next(0, cur)) return;
    f32x4 acc[2][2][4][2];
#pragma unroll
    for (int a = 0; a < 2; ++a)
#pragma unroll
        for (int b = 0; b < 2; ++b)
#pragma unroll
            for (int m = 0; m < 4; ++m)
#pragma unroll
                for (int n = 0; n < 2; ++n) acc[a][b][m][n] = (f32x4){0.f, 0.f, 0.f, 0.f};
    bf16x8 At[4][2], B0[2][2], B1[2][2];
    const char* cA = (const char*)g.A + (size_t)cur.pm * tsA; const char* cB = (const char*)g.Bt + (size_t)cur.pn * tsB;
    PG8_STAGE(PG8_SB(0, 0), cB, voffB); PG8_STAGE(PG8_SB(0, 1), cB + hsB, voffB); PG8_STAGE(PG8_SA(0, 0), cA, voffA); PG8_STAGE(PG8_SA(0, 1), cA + hsA, voffA);
    if (wr == 1) PG8_BAR;
    PG8_WAIT_V(2); PG8_BAR;
    PG8_STAGE(PG8_SB(1, 0), cB + kstep, voffB); PG8_STAGE(PG8_SA(1, 0), cA + kstep, voffA); PG8_STAGE(PG8_SB(1, 1), cB + hsB + kstep, voffB);
    PG8_WAIT_V(6); PG8_BAR;
    for (;;) {
        const bool has_next = S.next(ui + 1, nxt);
        const char* nA = has_next ? (const char*)g.A + (size_t)nxt.pm * tsA : cA; const char* nB = has_next ? (const char*)g.Bt + (size_t)nxt.pn * tsB : cB;
        for (int t = 0; t < nt; t += 2) {
            const bool last = (t == nt - 2);
            const char* a1 = cA + (size_t)(t + 1) * kstep;
            const char* a2 = last ? nA : cA + (size_t)(t + 2) * kstep; const char* b2 = last ? nB : cB + (size_t)(t + 2) * kstep;
            const char* a3 = a2 + kstep; const char* b3 = b2 + kstep;
            PG8_LDB(B0, 0, 0); PG8_LDB(B1, 0, 1); PG8_SCHED; PG8_LDA(At, 0, 0); PG8_STAGE(PG8_SA(1, 1), a1 + hsA, voffA);
            PG8_WAIT_V(8); PG8_WAIT_L(0); PG8_BAR; PG8_MMA(0, 0, At, B0); PG8_MMA(0, 1, At, B1); PG8_BAR; PG8_SCHED;
            PG8_LDA(At, 0, 1); PG8_STAGE(PG8_SB(0, 0), b2, voffB); PG8_STAGE(PG8_SB(0, 1), b2 + hsB, voffB); PG8_STAGE(PG8_SA(0, 0), a2, voffA);
            PG8_WAIT_V(8); PG8_WAIT_L(0); PG8_BAR; PG8_MMA(1, 0, At, B0); PG8_MMA(1, 1, At, B1); PG8_BAR; PG8_SCHED;
            PG8_LDB(B0, 1, 0); PG8_LDB(B1, 1, 1); PG8_SCHED; PG8_LDA(At, 1, 0); PG8_STAGE(PG8_SA(0, 1), a2 + hsA, voffA);
            PG8_WAIT_V(8); PG8_WAIT_L(0); PG8_BAR; PG8_MMA(0, 0, At, B0); PG8_MMA(0, 1, At, B1); PG8_BAR; PG8_SCHED;
            PG8_LDA(At, 1, 1); PG8_STAGE(PG8_SB(1, 0), b3, voffB); PG8_STAGE(PG8_SB(1, 1), b3 + hsB, voffB); PG8_STAGE(PG8_SA(1, 0), a3, voffA);
            PG8_WAIT_V(8); PG8_WAIT_L(0); PG8_BAR; PG8_MMA(1, 0, At, B0); PG8_MMA(1, 1, At, B1); PG8_BAR; PG8_SCHED;
        }
        if constexpr (ALIGN_EPI) { if (wr == 0) PG8_BAR; }
        E(acc, cur, wr, wc, fr, fq);
        if (!has_next) break;
#pragma unroll
        for (int a = 0; a < 2; ++a)
#pragma unroll
            for (int b = 0; b < 2; ++b)
#pragma unroll
                for (int m = 0; m < 4; ++m)
#pragma unroll
                    for (int n = 0; n < 2; ++n) acc[a][b][m][n] = (f32x4){0.f, 0.f, 0.f, 0.f};
        cur = nxt; cA = nA; cB = nB; ++ui;
        if constexpr (ALIGN_EPI) { if (wr == 1) PG8_BAR; }
    }
    PG8_WAIT_V(0);
    if constexpr (!ALIGN_EPI) { if (wr == 0) PG8_BAR; }
    PG8_BAR;
#undef PG8_SA
#undef PG8_SB
#undef PG8_STAGE
#undef PG8_LDA
#undef PG8_LDB
#undef PG8_MMA
#undef PG8_WAIT_V
#undef PG8_WAIT_L
#undef PG8_BAR
#undef PG8_SCHED
}
}
using pg8::cvt_pk_bf16;

__device__ __forceinline__ float bf2f(unsigned v) { return __uint_as_float(v << 16); }
__device__ __forceinline__ float bflo(unsigned w) { return __uint_as_float(w << 16); }
__device__ __forceinline__ float bfhi(unsigned w) { return __uint_as_float(w & 0xffff0000u); }
__device__ __forceinline__ unsigned short f2bf(float f) { return (unsigned short)(cvt_pk_bf16(f, 0.f) & 0xffffu); }
__device__ __forceinline__ float sigmoidf_(float x) { return 1.0f / (1.0f + __expf(-x)); }
__device__ __forceinline__ float siluf_(float x) { return x * sigmoidf_(x); }
__device__ __forceinline__ float gelu_tanh(float y) { const float z = 0.7978845608028654f * (y + 0.044715f * y * y * y); const float t = 1.0f - 2.0f / (1.0f + __expf(2.0f * z)); return 0.5f * y * (1.0f + t); }
__device__ __forceinline__ float wave_sum(float v) {
#pragma unroll
    for (int o = 1; o < 64; o <<= 1) v += __shfl_xor(v, o);
    return v;
}
#define LDS_WAIT() asm volatile("s_waitcnt lgkmcnt(0)" ::: "memory")

struct EpiSwiglu {
    static constexpr bool PERM = true;
    bf16_t* O; int ldc;
    __device__ __forceinline__ void operator()(const f32x4 (&acc)[2][2][4][2], const pg8::Unit& u, int wr, int wc, int fr, int fq) const {
        const int row0 = u.pm * 256 + wr * 64 + fr, col0 = u.pn * 128 + wc * 32 + 8 * fq;
#pragma unroll
        for (int ai = 0; ai < 2; ++ai)
#pragma unroll
            for (int m = 0; m < 4; ++m) {
                const f32x4 g0 = acc[ai][0][m][0], g1 = acc[ai][0][m][1], u0 = acc[ai][1][m][0], u1 = acc[ai][1][m][1];
                u32x4 w;
                w.x = cvt_pk_bf16(siluf_(g0[0]) * u0[0], siluf_(g0[1]) * u0[1]); w.y = cvt_pk_bf16(siluf_(g0[2]) * u0[2], siluf_(g0[3]) * u0[3]);
                w.z = cvt_pk_bf16(siluf_(g1[0]) * u1[0], siluf_(g1[1]) * u1[1]); w.w = cvt_pk_bf16(siluf_(g1[2]) * u1[2], siluf_(g1[3]) * u1[3]);
                *(u32x4*)(O + (size_t)(row0 + ai * 128 + m * 16) * ldc + col0) = w;
                asm volatile("" ::: "memory");
            }
    }
};
struct EpiYraw {
    static constexpr bool PERM = true;
    bf16_t* O; float* part;
    __device__ __forceinline__ void operator()(const f32x4 (&acc)[2][2][4][2], const pg8::Unit& u, int wr, int wc, int fr, int fq) const {
        const int row0 = u.pm * 256 + wr * 64 + fr, col0 = u.pn * 256 + wc * 32 + 8 * fq;
#pragma unroll
        for (int ai = 0; ai < 2; ++ai)
#pragma unroll
            for (int m = 0; m < 4; ++m) {
                const int row = row0 + ai * 128 + m * 16; float ss = 0.f;
#pragma unroll
                for (int bj = 0; bj < 2; ++bj) { const f32x4 v0 = acc[ai][bj][m][0], v1 = acc[ai][bj][m][1];
                    ss += (v0[0] * v0[0] + v0[1] * v0[1]) + (v0[2] * v0[2] + v0[3] * v0[3]) + (v1[0] * v1[0] + v1[1] * v1[1]) + (v1[2] * v1[2] + v1[3] * v1[3]);
                    u32x4 w; w.x = cvt_pk_bf16(v0[0], v0[1]); w.y = cvt_pk_bf16(v0[2], v0[3]); w.z = cvt_pk_bf16(v1[0], v1[1]); w.w = cvt_pk_bf16(v1[2], v1[3]);
                    *(u32x4*)(O + (size_t)row * DM + col0 + bj * 128) = w; }
                ss += __shfl_xor(ss, 16); ss += __shfl_xor(ss, 32);
                if (fq == 0) part[(size_t)row * 16 + u.pn * 4 + wc] = ss;
                asm volatile("" ::: "memory");
            }
    }
};
struct EpiInproj {
    static constexpr bool PERM = true;
    bf16_t *QKV, *Z, *U; float *BETA, *G; const float *a_log, *dt_bias;
    __device__ __forceinline__ void operator()(const f32x4 (&acc)[2][2][4][2], const pg8::Unit& u, int wr, int wc, int fr, int fq) const {
        const int row0 = u.pm * 256 + wr * 64 + fr;
        if (u.pn == 10) {
            if (wc == 0 && fq == 0) {
                const f32x4 al = *(const f32x4*)a_log, db = *(const f32x4*)dt_bias;
#pragma unroll
                for (int ai = 0; ai < 2; ++ai)
#pragma unroll
                    for (int m = 0; m < 4; ++m) { const int row = row0 + ai * 128 + m * 16; const f32x4 bi = acc[ai][0][m][0], an = acc[ai][0][m][1]; f32x4 bo, go;
#pragma unroll
                        for (int j = 0; j < 4; ++j) { bo[j] = 1.0f / (1.0f + expf(-bi[j])); const float xx = an[j] + db[j]; const float sp = xx > 20.f ? xx : log1pf(expf(xx)); go[j] = -expf(al[j]) * sp; }
                        *(f32x4*)(BETA + (size_t)row * 4) = bo; *(f32x4*)(G + (size_t)row * 4) = go; asm volatile("" ::: "memory"); }
            }
            return;
        }
        bf16_t* base; int ldc, colt;
        if (u.pn < 6) { base = QKV; ldc = 1536; colt = u.pn * 256; } else if (u.pn < 8) { base = Z; ldc = 512; colt = (u.pn - 6) * 256; } else { base = U; ldc = 512; colt = (u.pn - 8) * 256; }
        const int col0 = colt + wc * 32 + 8 * fq;
#pragma unroll
        for (int ai = 0; ai < 2; ++ai)
#pragma unroll
            for (int m = 0; m < 4; ++m)
#pragma unroll
                for (int bj = 0; bj < 2; ++bj) { const f32x4 v0 = acc[ai][bj][m][0], v1 = acc[ai][bj][m][1];
                    u32x4 w; w.x = cvt_pk_bf16(v0[0], v0[1]); w.y = cvt_pk_bf16(v0[2], v0[3]); w.z = cvt_pk_bf16(v1[0], v1[1]); w.w = cvt_pk_bf16(v1[2], v1[3]);
                    *(u32x4*)(base + (size_t)(row0 + ai * 128 + m * 16) * ldc + col0 + bj * 128) = w; asm volatile("" ::: "memory"); }
    }
};
struct EpiGlu {
    static constexpr bool PERM = true;
    const bf16_t* YS; bf16_t* YCAT;
    __device__ __forceinline__ void operator()(const f32x4 (&acc)[2][2][4][2], const pg8::Unit& u, int wr, int wc, int fr, int fq) const {
        const int row0 = u.pm * 256 + wr * 64 + fr, col0 = u.pn * 256 + wc * 32 + 8 * fq;
#pragma unroll
        for (int ai = 0; ai < 2; ++ai)
#pragma unroll
            for (int m = 0; m < 4; ++m)
#pragma unroll
                for (int bj = 0; bj < 2; ++bj) { const int row = row0 + ai * 128 + m * 16, col = col0 + bj * 128;
                    const u32x4 y = *(const u32x4*)(YS + (size_t)row * 512 + col); const f32x4 v0 = acc[ai][bj][m][0], v1 = acc[ai][bj][m][1];
                    u32x4 w; w.x = cvt_pk_bf16(bflo(y.x) * sigmoidf_(v0[0]), bfhi(y.x) * sigmoidf_(v0[1])); w.y = cvt_pk_bf16(bflo(y.y) * sigmoidf_(v0[2]), bfhi(y.y) * sigmoidf_(v0[3]));
                    w.z = cvt_pk_bf16(bflo(y.z) * sigmoidf_(v1[0]), bfhi(y.z) * sigmoidf_(v1[1])); w.w = cvt_pk_bf16(bflo(y.w) * sigmoidf_(v1[2]), bfhi(y.w) * sigmoidf_(v1[3]));
                    *(u32x4*)(YCAT + (size_t)row * DM + 512 + col) = w; asm volatile("" ::: "memory"); }
    }
};

constexpr size_t MiB = 1u << 20;
constexpr size_t W_FF_IN = (size_t)2 * DFF * DM * 2, W_FF_OUT = (size_t)DM * DFF * 2, W_MIX_IN = (size_t)MIXN * DM * 2, W_GLU = 512 * 512 * 2, W_MIX_OUT = (size_t)DM * DM * 2;
constexpr size_t WO_FF1_IN = 0, WO_FF1_OUT = WO_FF1_IN + W_FF_IN, WO_MIX_IN = WO_FF1_OUT + W_FF_OUT, WO_GLU = WO_MIX_IN + W_MIX_IN, WO_MIX_OUT = WO_GLU + W_GLU,
                 WO_FF2_IN = WO_MIX_OUT + W_MIX_OUT, WO_FF2_OUT = WO_FF2_IN + W_FF_IN, W_LAYER = WO_FF2_OUT + W_FF_OUT;
static_assert(W_LAYER * 2 <= 84 * MiB, "weights");
constexpr size_t WS_W = 0, WS_H = 84 * MiB, WS_BIG = 148 * MiB, WS_YR = 324 * MiB, WS_EX = 388 * MiB, WS_SMALL = 500 * MiB, WS_END = 512 * MiB;
constexpr size_t WS_QKV = WS_BIG, WS_Z = WS_BIG + 96 * MiB, WS_U = WS_BIG + 128 * MiB;
constexpr size_t WS_SC = WS_BIG;
constexpr size_t WS_D = WS_EX, WS_RT = WS_YR;
constexpr size_t WS_QP = WS_H, WS_O0T = WS_H + 32 * MiB;
constexpr size_t WS_YS = WS_EX + 64 * MiB;
constexpr size_t WS_YCAT = WS_EX;
constexpr size_t WS_PART = WS_SMALL, WS_MOD = WS_PART + 2 * MiB, WS_BETA = WS_MOD + 1 * MiB, WS_G = WS_BETA + 1 * MiB, WS_EGL = WS_G + 1 * MiB, WS_S5E = WS_EGL + 1 * MiB;
static_assert(WS_S5E + 2 * MiB <= WS_END, "small");
constexpr int LDS_BYTES = 147456;
#ifndef REP_A
#define REP_A 1
#endif
#ifndef REP_B
#define REP_B 1
#endif
#ifndef REP_C
#define REP_C 1
#endif
constexpr size_t WS_CTL = WS_SMALL + 10 * MiB, CTL_BYTES = 16384;

struct Args { const float* in[29]; float* out; unsigned char* ws; int rep_a, rep_b, rep_c, pad; };

__device__ __forceinline__ int src_col(int maptype, int n) {
    if (maptype == 0) return n;
    if (maptype == 1) { const int t = n >> 8, w = n & 255; return (w < 128) ? t * 128 + w : DFF + t * 128 + (w - 128); }
    return n < 2048 ? n : (n < 2560 ? n + 8 : (n < 2568 ? n - 512 : -1));
}
__device__ __forceinline__ void transpose_item(const float* W, int K, int N, bf16_t* WT, LAS float* scr, int kb, int nb, int maptype, int lane) {
    const int k0 = 64 * kb, n0 = 32 * nb; const int sc = src_col(maptype, n0 + (lane & 31));
#pragma unroll 8
    for (int i = 0; i < 32; ++i) { const int kk = 2 * i + (lane >> 5); scr[kk * 33 + (lane & 31)] = sc >= 0 ? W[(size_t)(k0 + kk) * N + sc] : 0.f; }
    LDS_WAIT(); asm volatile("" ::: "memory");
    const int c = lane & 7;
#pragma unroll
    for (int j = 0; j < 4; ++j) { const int n = (lane >> 3) + 8 * j; const LAS float* s = scr + (8 * c) * 33 + n;
        u32x4 o; o.x = cvt_pk_bf16(s[0 * 33], s[1 * 33]); o.y = cvt_pk_bf16(s[2 * 33], s[3 * 33]); o.z = cvt_pk_bf16(s[4 * 33], s[5 * 33]); o.w = cvt_pk_bf16(s[6 * 33], s[7 * 33]);
        *(u32x4*)(WT + (size_t)(n0 + n) * K + k0 + 8 * c) = o; }
    LDS_WAIT(); asm volatile("" ::: "memory");
}

__device__ __forceinline__ void finalize_phase(const float* xsrc, float* xdst, const bf16_t* yraw, const float* part, const float* gate  , float gs, const float* wpost,
                                               const float* wpre, const float* shift, const float* scale, bf16_t* H, int gw, int NGW, int lane) {
    asm volatile("" : "+v"(lane));
    for (int m = gw; m < M; m += NGW) {
        const int b = m / SEQ;
        f32x4 x[4];
#pragma unroll
        for (int j = 0; j < 4; ++j) x[j] = *(const f32x4*)(xsrc + (size_t)m * DM + 4 * lane + 256 * j);
        if (yraw) {
            float ss = 0.f;
#pragma unroll
            for (int q = 0; q < 4; ++q) { const f32x4 p = *(const f32x4*)(part + (size_t)m * 16 + 4 * q); ss += (p[0] + p[1]) + (p[2] + p[3]); }
            const float rstd = rsqrtf(ss * (1.0f / DM) + EPS) * gs;
#pragma unroll
            for (int j = 0; j < 4; ++j) { const int col = 4 * lane + 256 * j; const u32x2 y = *(const u32x2*)(yraw + (size_t)m * DM + col);
                const f32x4 gt = *(const f32x4*)(gate + (size_t)b * NMOD + col), wp = *(const f32x4*)(wpost + col);
                x[j][0] += gt[0] * wp[0] * rstd * bflo(y.x); x[j][1] += gt[1] * wp[1] * rstd * bfhi(y.x); x[j][2] += gt[2] * wp[2] * rstd * bflo(y.y); x[j][3] += gt[3] * wp[3] * rstd * bfhi(y.y);
                *(f32x4*)(xdst + (size_t)m * DM + col) = x[j]; }
        }
        if (H) {
            float s2 = 0.f;
#pragma unroll
            for (int j = 0; j < 4; ++j) s2 += (x[j][0] * x[j][0] + x[j][1] * x[j][1]) + (x[j][2] * x[j][2] + x[j][3] * x[j][3]);
            const float r2 = rsqrtf(wave_sum(s2) * (1.0f / DM) + EPS);
#pragma unroll
            for (int j = 0; j < 4; ++j) { const int col = 4 * lane + 256 * j; const f32x4 wp = *(const f32x4*)(wpre + col), sh = *(const f32x4*)(shift + (size_t)b * NMOD + col), sc = *(const f32x4*)(scale + (size_t)b * NMOD + col);
                u32x2 o; o.x = cvt_pk_bf16(x[j][0] * r2 * wp[0] * (1.f + sc[0]) + sh[0], x[j][1] * r2 * wp[1] * (1.f + sc[1]) + sh[1]);
                o.y = cvt_pk_bf16(x[j][2] * r2 * wp[2] * (1.f + sc[2]) + sh[2], x[j][3] * r2 * wp[3] * (1.f + sc[3]) + sh[3]);
                *(u32x2*)(H + (size_t)m * DM + col) = o; }
        }
    }
}

__device__ __forceinline__ f32x4 mma_nt(lp_t A, int lda_b, lp_t B, int ldb_b, int nkt, int fr, int fq, f32x4 acc) {
    for (int kt = 0; kt < nkt; ++kt) {
        const bf16x8 a = *(const LAS bf16x8*)(A + fr * lda_b + (kt * 32 + fq * 8) * 2);
        const bf16x8 b = *(const LAS bf16x8*)(B + fr * ldb_b + (kt * 32 + fq * 8) * 2);
        acc = __builtin_amdgcn_mfma_f32_16x16x32_bf16(a, b, acc, 0, 0, 0);
    }
    return acc;
}

constexpr int GP_KN = 0, GP_QS = 17408, GP_V = 34816, GP_KST = 51200, GP_ATT = 67584, GP_A = 76800, GP_TT = 93184, GP_GC = 130048, GP_BETA = 130304, GP_BG = 130560, GP_END = 130816;
constexpr int LD136 = 272, LD72 = 144, LDV = 256, LDKS = 128;
__device__ __forceinline__ void gdn_pre_unit(lp_t lds, int u, const bf16_t* QKV, const float* convw, const float* BETA, const float* G,
                                             bf16_t* Dg, bf16_t* RTg, bf16_t* QPg, bf16_t* O0Tg, float* EGL) {
    int tid_ = threadIdx.x; asm volatile("" : "+v"(tid_));
    const int tid = tid_, wid = __builtin_amdgcn_readfirstlane(tid >> 6), lane = tid & 63, fr = lane & 15, fq = lane >> 4;
    const int b = u >> 9, h = (u >> 7) & 3, c = u & 127;
    const size_t row0 = (size_t)b * SEQ + (size_t)c * CH;
    LAS float* sGC = (LAS float*)(lds + GP_GC); LAS float* sBE = (LAS float*)(lds + GP_BETA);
    if (wid == 0) {
        float v = G[(row0 + lane) * 4 + h];
#ifdef DBG_CONST_GB
        v = -0.01f;
#endif
#pragma unroll
        for (int o = 1; o < 64; o <<= 1) { const float t = __shfl_up(v, o); if (lane >= o) v += t; }
        float be = BETA[(row0 + lane) * 4 + h];
#ifdef DBG_CONST_GB
        be = 0.5f;
#endif
        sGC[lane] = v; sBE[lane] = be; *(LAS float*)(lds + GP_BG + lane * 4) = be * expf(v);
    }
    __syncthreads();
    const float gl = sGC[63];
    {
        const int i = tid >> 3, d0 = (tid & 7) * 16; const float gci = sGC[i];
        u32x4 xq[3][4][2];
#pragma unroll
        for (int part = 0; part < 3; ++part)
#pragma unroll
            for (int j = 0; j < 4; ++j) {
                const int t = c * CH + i - 3 + j; const int tc = t >= 0 ? t : 0;
                const bf16_t* src = QKV + ((size_t)b * SEQ + tc) * 1536 + part * 512 + h * 128 + d0;
                u32x4 x0 = *(const u32x4*)src, x1 = *(const u32x4*)(src + 8);
                if (t < 0) { x0 = (u32x4){0u, 0u, 0u, 0u}; x1 = x0; }
                xq[part][j][0] = x0; xq[part][j][1] = x1;
            }
#pragma unroll
        for (int part = 0; part < 3; ++part) {
            const int ch0 = part * 512 + h * 128 + d0;
            float a[16];
#pragma unroll
            for (int e = 0; e < 16; ++e) a[e] = 0.f;
#pragma unroll
            for (int j = 0; j < 4; ++j) {
                const float* wj = convw + j * 1536 + ch0; const u32x4 x0 = xq[part][j][0], x1 = xq[part][j][1];
                const f32x4 w0 = *(const f32x4*)wj, w1 = *(const f32x4*)(wj + 4), w2 = *(const f32x4*)(wj + 8), w3 = *(const f32x4*)(wj + 12);
                a[0] += w0[0] * bflo(x0.x); a[1] += w0[1] * bfhi(x0.x); a[2] += w0[2] * bflo(x0.y); a[3] += w0[3] * bfhi(x0.y);
                a[4] += w1[0] * bflo(x0.z); a[5] += w1[1] * bfhi(x0.z); a[6] += w1[2] * bflo(x0.w); a[7] += w1[3] * bfhi(x0.w);
                a[8] += w2[0] * bflo(x1.x); a[9] += w2[1] * bfhi(x1.x); a[10] += w2[2] * bflo(x1.y); a[11] += w2[3] * bfhi(x1.y);
                a[12] += w3[0] * bflo(x1.z); a[13] += w3[1] * bfhi(x1.z); a[14] += w3[2] * bflo(x1.w); a[15] += w3[3] * bfhi(x1.w);
            }
            float ss = 0.f;
#pragma unroll
            for (int e = 0; e < 16; ++e) { a[e] = a[e] / (1.0f + __expf(-a[e])); ss += a[e] * a[e]; }
            ss += __shfl_xor(ss, 1); ss += __shfl_xor(ss, 2); ss += __shfl_xor(ss, 4);
            float sc = 1.f;
            if (part == 0) sc = rsqrtf(ss + EPS) * 0.08838834764831845f; else if (part == 1) sc = rsqrtf(ss + EPS);
            const lp_t dst = lds + (part == 0 ? GP_QS : (part == 1 ? GP_KN : GP_V)) + i * (part == 2 ? LDV : LD136) + d0 * 2;
            u32x4 o0, o1;
            o0.x = cvt_pk_bf16(a[0] * sc, a[1] * sc); o0.y = cvt_pk_bf16(a[2] * sc, a[3] * sc); o0.z = cvt_pk_bf16(a[4] * sc, a[5] * sc); o0.w = cvt_pk_bf16(a[6] * sc, a[7] * sc);
            o1.x = cvt_pk_bf16(a[8] * sc, a[9] * sc); o1.y = cvt_pk_bf16(a[10] * sc, a[11] * sc); o1.z = cvt_pk_bf16(a[12] * sc, a[13] * sc); o1.w = cvt_pk_bf16(a[14] * sc, a[15] * sc);
            *(LAS u32x4*)dst = o0; *(LAS u32x4*)(dst + 16) = o1;
            if (part == 1) { const float ks = sc * expf(gl - gci);
#pragma unroll
                for (int e = 0; e < 16; ++e) *(LAS unsigned short*)(lds + GP_KST + (d0 + e) * LDKS + i * 2) = f2bf(a[e] * ks); }
        }
    }
    __syncthreads();
    {
#pragma unroll 1
        for (int q = 0; q < 4; ++q) {
            const int idx = wid * 4 + q, isq = idx >> 4, mt = (idx >> 2) & 3, nt = idx & 3;
            f32x4 acc = (f32x4){0.f, 0.f, 0.f, 0.f};
            acc = mma_nt(lds + (isq ? GP_QS : GP_KN) + mt * 16 * LD136, LD136, lds + GP_KN + nt * 16 * LD136, LD136, 4, fr, fq, acc);
            const int jc = nt * 16 + fr; const float gcj = sGC[jc];
#pragma unroll
            for (int jj = 0; jj < 4; ++jj) { const int i = mt * 16 + 4 * fq + jj; const float dec = expf(fminf(sGC[i] - gcj, 0.f));
                if (isq) *(LAS unsigned short*)(lds + GP_ATT + i * LD72 + jc * 2) = f2bf(i >= jc ? acc[jj] * dec : 0.f);
                else *(LAS float*)(lds + GP_A + (i * 64 + jc) * 4) = (i > jc) ? sBE[i] * acc[jj] * dec : 0.f; }
        }
    }
    __syncthreads();
    if (wid < 4) {
        const int col = wid * 64 + lane;
        unsigned lbA = (unsigned)(size_t)(lds + GP_A), lbS = (unsigned)(size_t)(lds + (wid < 2 ? GP_BETA : GP_BG));
        asm volatile("" : "+v"(lbA), "+v"(lbS));
        const lp_t pA = (lp_t)lbA, pS = (lp_t)lbS;
        const lp_t pR = (wid < 2) ? (lds + GP_V + col * 2) : (lds + GP_KN + (col - 128) * 2);
        float T[64];
#pragma unroll
        for (int i = 0; i < 64; ++i) {
            float acc = *(const LAS float*)(pS + i * 4) * bf2f(*(const LAS unsigned short*)(pR + i * (wid < 2 ? LDV : LD136)));
#pragma unroll
#ifdef DBG_NOSOLVE
            for (int j4 = 0; j4 < 0; ++j4) { const f32x4 a = *(const LAS f32x4*)(pA + (i * 64 + j4 * 4) * 4);
#else
            for (int j4 = 0; j4 < (i + 3) / 4; ++j4) { const f32x4 a = *(const LAS f32x4*)(pA + (i * 64 + j4 * 4) * 4);
#endif
                acc = __builtin_fmaf(-a[0], T[j4 * 4], acc);
                if (j4 * 4 + 1 < i) acc = __builtin_fmaf(-a[1], T[j4 * 4 + 1], acc);
                if (j4 * 4 + 2 < i) acc = __builtin_fmaf(-a[2], T[j4 * 4 + 2], acc);
                if (j4 * 4 + 3 < i) acc = __builtin_fmaf(-a[3], T[j4 * 4 + 3], acc); }
            T[i] = acc;
            asm volatile("" ::: "memory");
        }
        const lp_t pT = lds + GP_TT + col * LD72;
#pragma unroll
        for (int q = 0; q < 8; ++q) { u32x4 o; o.x = cvt_pk_bf16(T[8 * q], T[8 * q + 1]); o.y = cvt_pk_bf16(T[8 * q + 2], T[8 * q + 3]); o.z = cvt_pk_bf16(T[8 * q + 4], T[8 * q + 5]); o.w = cvt_pk_bf16(T[8 * q + 6], T[8 * q + 7]);
            *(LAS u32x4*)(pT + q * 16) = o; }
    }
    __syncthreads();
    {
        bf16_t* Du = Dg + (size_t)u * 16384; bf16_t* RTu = RTg + (size_t)u * 16384; bf16_t* QPu = QPg + (size_t)u * 8192; bf16_t* O0u = O0Tg + (size_t)u * 8192;
#pragma unroll 1
        for (int q = 0; q < 24; ++q) {
            const int idx = wid * 24 + q;
            f32x4 acc = (f32x4){0.f, 0.f, 0.f, 0.f};
            if (idx < 32) {
                const int dt = idx >> 2, it = idx & 3;
                acc = mma_nt(lds + GP_TT + (128 + dt * 16) * LD72, LD72, lds + GP_ATT + it * 16 * LD72, LD72, 2, fr, fq, acc);
                const int i = it * 16 + fr, d = dt * 16 + 4 * fq; const float eg = expf(sGC[i]);
                const u32x2 qv = *(const LAS u32x2*)(lds + GP_QS + i * LD136 + d * 2);
                u32x2 o; o.x = cvt_pk_bf16(bflo(qv.x) * eg - acc[0], bfhi(qv.x) * eg - acc[1]); o.y = cvt_pk_bf16(bflo(qv.y) * eg - acc[2], bfhi(qv.y) * eg - acc[3]);
                *(u32x2*)(QPu + i * 128 + d) = o;
            } else if (idx < 64) {
                const int it = (idx - 32) >> 3, nt = (idx - 32) & 7;
                acc = mma_nt(lds + GP_ATT + it * 16 * LD72, LD72, lds + GP_TT + nt * 16 * LD72, LD72, 2, fr, fq, acc);
                const int n = nt * 16 + fr, i = it * 16 + 4 * fq;
#ifdef DBG_O0PATTERN
                acc[0] = 0.01f * (float)((n + i) & 31); acc[1] = -acc[0]; acc[2] = 0.5f * acc[0]; acc[3] = 0.25f;
#endif
                u32x2 o; o.x = cvt_pk_bf16(acc[0], acc[1]); o.y = cvt_pk_bf16(acc[2], acc[3]);
                *(u32x2*)(O0u + n * 64 + i) = o;
            } else if (idx < 128) {
                const int kt = (idx - 64) >> 3, mt = (idx - 64) & 7;
                acc = mma_nt(lds + GP_TT + (128 + kt * 16) * LD72, LD72, lds + GP_KST + mt * 16 * LDKS, LDKS, 2, fr, fq, acc);
                const int m = mt * 16 + fr, k = kt * 16 + 4 * fq;
                u32x2 o; o.x = cvt_pk_bf16(acc[0], acc[1]); o.y = cvt_pk_bf16(acc[2], acc[3]);
                *(u32x2*)(Du + m * 128 + k) = o;
            } else {
                const int mt = (idx - 128) >> 3, nt = (idx - 128) & 7;
                acc = mma_nt(lds + GP_KST + mt * 16 * LDKS, LDKS, lds + GP_TT + nt * 16 * LD72, LD72, 2, fr, fq, acc);
                const int n = nt * 16 + fr, m = mt * 16 + 4 * fq;
                u32x2 o; o.x = cvt_pk_bf16(acc[0], acc[1]); o.y = cvt_pk_bf16(acc[2], acc[3]);
                *(u32x2*)(RTu + n * 128 + m) = o;
            }
        }
        if (tid == 0) EGL[u] = expf(gl);
    }
    __syncthreads();
}

struct ScanSet { bf16x8 d[2][4]; u32x2 r[2][2]; float egl; };
__device__ __forceinline__ void scan_load(ScanSet& R, const bf16_t* Dg, const bf16_t* RTg, const float* EGL, int u, unsigned offD, unsigned offR) {
    const bf16_t* Du = Dg + (size_t)u * 16384; const bf16_t* RTu = RTg + (size_t)u * 16384;
#pragma unroll
    for (int mt = 0; mt < 2; ++mt) {
#pragma unroll
        for (int kt = 0; kt < 4; ++kt) R.d[mt][kt] = *(const bf16x8*)(Du + offD + mt * 16 * 128 + kt * 32);
#pragma unroll
        for (int nt = 0; nt < 2; ++nt) R.r[mt][nt] = *(const u32x2*)(RTu + offR + nt * 16 * 128 + mt * 16);
    }
    R.egl = EGL[u];
}
__device__ __forceinline__ void scan_step(lp_t lds, int cur, const ScanSet& R, f32x4 (&acc)[2][2], bf16_t* SCg, int u, int cq, int rq, unsigned offS, int fr, int fq) {
    const lp_t img = lds + cur * 17408 + (32 * cq + fr) * LD136 + fq * 16, nimg = lds + (cur ^ 1) * 17408 + (32 * cq + fr) * LD136 + (32 * rq + 4 * fq) * 2;
    bf16_t* SCu = SCg + (size_t)u * 16384 + offS;
#pragma unroll
    for (int nt = 0; nt < 2; ++nt) {
        bf16x8 b[4];
#pragma unroll
        for (int kt = 0; kt < 4; ++kt) b[kt] = *(const LAS bf16x8*)(img + nt * 16 * LD136 + kt * 64);
        *(bf16x8*)(SCu + nt * 2048) = (rq == 0) ? b[0] : ((rq == 1) ? b[1] : ((rq == 2) ? b[2] : b[3]));
#pragma unroll
        for (int mt = 0; mt < 2; ++mt) {
            f32x4 t = (f32x4){0.f, 0.f, 0.f, 0.f};
#pragma unroll
            for (int kt = 0; kt < 4; ++kt) t = __builtin_amdgcn_mfma_f32_16x16x32_bf16(R.d[mt][kt], b[kt], t, 0, 0, 0);
            f32x4& a = acc[mt][nt]; const u32x2 r = R.r[mt][nt];
            a[0] = R.egl * a[0] + bflo(r.x) - t[0]; a[1] = R.egl * a[1] + bfhi(r.x) - t[1];
            a[2] = R.egl * a[2] + bflo(r.y) - t[2]; a[3] = R.egl * a[3] + bfhi(r.y) - t[3];
            u32x2 o; o.x = cvt_pk_bf16(a[0], a[1]); o.y = cvt_pk_bf16(a[2], a[3]);
            *(LAS u32x2*)(nimg + nt * 16 * LD136 + mt * 32) = o;
        }
        asm volatile("" ::: "memory");
    }
}
__device__ __forceinline__ void gdn_scan(lp_t lds, int bhh, const bf16_t* Dg, const bf16_t* RTg, const float* EGL, bf16_t* SCg) {
    int tid_ = threadIdx.x; asm volatile("" : "+v"(tid_));
    const int tid = tid_, wid = __builtin_amdgcn_readfirstlane(tid >> 6), lane = tid & 63, fr = lane & 15, fq = lane >> 4;
    const int bh = bhh >> 1, half = bhh & 1, cq = wid & 1, rq = wid >> 1, nb = half * 64 + 32 * cq, u0 = bh * NCH;
    unsigned offD = (unsigned)((32 * rq + fr) * 128 + 8 * fq), offR = (unsigned)((nb + fr) * 128 + 32 * rq + 4 * fq), offS = (unsigned)((nb + fr) * 128 + 32 * rq + 8 * fq);
    asm volatile("" : "+v"(offD), "+v"(offR), "+v"(offS));
    for (int i = tid; i < 2 * 17408 / 4; i += 512) ((LAS unsigned*)lds)[i] = 0u;
    f32x4 acc[2][2];
#pragma unroll
    for (int mt = 0; mt < 2; ++mt)
#pragma unroll
        for (int nt = 0; nt < 2; ++nt) acc[mt][nt] = (f32x4){0.f, 0.f, 0.f, 0.f};
    ScanSet R0, R1, R2;
    scan_load(R0, Dg, RTg, EGL, u0, offD, offR); scan_load(R1, Dg, RTg, EGL, u0 + 1, offD, offR);
    __syncthreads();
#define SCAN_CL(x) ((x) < NCH ? (x) : NCH - 1)
    int c = 0;
#pragma unroll 1
    for (; c + 2 < NCH; c += 3) {
        scan_load(R2, Dg, RTg, EGL, u0 + SCAN_CL(c + 2), offD, offR); scan_step(lds, c & 1, R0, acc, SCg, u0 + c, cq, rq, offS, fr, fq); __syncthreads();
        scan_load(R0, Dg, RTg, EGL, u0 + SCAN_CL(c + 3), offD, offR); scan_step(lds, (c + 1) & 1, R1, acc, SCg, u0 + c + 1, cq, rq, offS, fr, fq); __syncthreads();
        scan_load(R1, Dg, RTg, EGL, u0 + SCAN_CL(c + 4), offD, offR); scan_step(lds, c & 1, R2, acc, SCg, u0 + c + 2, cq, rq, offS, fr, fq); __syncthreads();
    }
    scan_step(lds, c & 1, R0, acc, SCg, u0 + c, cq, rq, offS, fr, fq); __syncthreads();
    scan_step(lds, (c + 1) & 1, R1, acc, SCg, u0 + c + 1, cq, rq, offS, fr, fq); __syncthreads();
#undef SCAN_CL
}

__device__ __forceinline__ void gdn_out_pair(int pairidx, const bf16_t* QPg, const bf16_t* O0Tg, const bf16_t* SCg, const bf16_t* Z, const float* gnw, bf16_t* YCAT) {
    int tid_ = threadIdx.x; asm volatile("" : "+v"(tid_));
    const int tid = tid_, wid = __builtin_amdgcn_readfirstlane(tid >> 6), lane = tid & 63, fr = lane & 15, fq = lane >> 4;
    const int u = pairidx * 2 + (wid >> 2), mt = wid & 3;
    const int b = u >> 9, h = (u >> 7) & 3, c = u & 127;
    const bf16_t* QPu = QPg + (size_t)u * 8192; const bf16_t* O0u = O0Tg + (size_t)u * 8192; const bf16_t* SCu = SCg + (size_t)u * 16384;
    bf16x8 a[4];
#pragma unroll
    for (int kt = 0; kt < 4; ++kt) a[kt] = *(const bf16x8*)(QPu + (16 * mt + fr) * 128 + 32 * kt + 8 * fq);
    f32x4 acc[8]; float ss[4] = {0.f, 0.f, 0.f, 0.f};
#pragma unroll
    for (int nt = 0; nt < 8; ++nt) {
        const u32x2 o0 = *(const u32x2*)(O0u + (16 * nt + fr) * 64 + 16 * mt + 4 * fq);
        acc[nt] = (f32x4){bflo(o0.x), bfhi(o0.x), bflo(o0.y), bfhi(o0.y)};
#ifndef DBG_NO_STATE
#pragma unroll
        for (int kt = 0; kt < 4; ++kt) { const bf16x8 bb = *(const bf16x8*)(SCu + (16 * nt + fr) * 128 + 32 * kt + 8 * fq); acc[nt] = __builtin_amdgcn_mfma_f32_16x16x32_bf16(a[kt], bb, acc[nt], 0, 0, 0); }
#endif
#pragma unroll
        for (int j = 0; j < 4; ++j) ss[j] += acc[nt][j] * acc[nt][j];
    }
#pragma unroll
    for (int j = 0; j < 4; ++j) { float s = ss[j]; s += __shfl_xor(s, 1); s += __shfl_xor(s, 2); s += __shfl_xor(s, 4); s += __shfl_xor(s, 8); ss[j] = rsqrtf(s * (1.0f / HD) + EPS); }
    const size_t row0 = (size_t)b * SEQ + (size_t)c * CH + 16 * mt + 4 * fq;
#pragma unroll
    for (int nt = 0; nt < 8; ++nt) { const int n = 16 * nt + fr; const float w = gnw[n];
#pragma unroll
        for (int j = 0; j < 4; ++j) { const float z = bf2f(Z[(row0 + j) * 512 + h * 128 + n]); float ov = acc[nt][j] * ss[j] * w * siluf_(z);
#ifdef DBG_GDN_ZERO
            ov = 0.f;
#endif
#ifdef DBG_ZONLY
            ov = siluf_(z) * w;
#endif
#ifdef DBG_O0ONLY
            ov = acc[nt][j];
#endif
#ifdef DBG_SANITIZE
            if (!(fabsf(ov) < 1e30f)) ov = 0.f;
#endif
            YCAT[(row0 + j) * DM + h * 128 + n] = f2bf(ov); } }
}

typedef short bf16x4 __attribute__((ext_vector_type(4)));
struct S5W { float are, aim; bf16x4 bre[4], bim[4]; };
__device__ __forceinline__ void s5_abar(int g, int p, const float* a_re, const float* a_im, const float* log_dt, float& are, float& aim, float& f_r, float& f_i) {
    const float ar = fminf(a_re[g * 64 + p], -1e-4f), ai = a_im[g * 64 + p], dt = expf(log_dt[g]);
    const float mag = expf(dt * ar); are = mag * cosf(dt * ai); aim = mag * sinf(dt * ai);
    const float den = ar * ar + ai * ai, zr = are - 1.0f, zi = aim; f_r = (zr * ar + zi * ai) / den; f_i = (zi * ar - zr * ai) / den;
}
__device__ __forceinline__ void s5_setup(S5W& W, int g, int lane, const float* a_re, const float* a_im, const float* log_dt, const float* b_re, const float* b_im) {
    float t0, t1; s5_abar(g, lane, a_re, a_im, log_dt, W.are, W.aim, t0, t1);
    const int fr = lane & 15, fq = lane >> 4;
#pragma unroll
    for (int nt = 0; nt < 4; ++nt) { float a_, b_, f_r, f_i; const int p = 16 * nt + fr; s5_abar(g, p, a_re, a_im, log_dt, a_, b_, f_r, f_i);
        const f32x4 br = *(const f32x4*)(b_re + (size_t)(g * 64 + p) * 16 + 4 * fq), bi = *(const f32x4*)(b_im + (size_t)(g * 64 + p) * 16 + 4 * fq);
        u32x2 w; w.x = cvt_pk_bf16(f_r * br[0] - f_i * bi[0], f_r * br[1] - f_i * bi[1]); w.y = cvt_pk_bf16(f_r * br[2] - f_i * bi[2], f_r * br[3] - f_i * bi[3]); W.bre[nt] = __builtin_bit_cast(bf16x4, w);
        w.x = cvt_pk_bf16(f_r * bi[0] + f_i * br[0], f_r * bi[1] + f_i * br[1]); w.y = cvt_pk_bf16(f_r * bi[2] + f_i * br[2], f_r * bi[3] + f_i * br[3]); W.bim[nt] = __builtin_bit_cast(bf16x4, w); }
}
constexpr int S5_BUT = 0, S5_LDB = 80, S5_XT = 10240, S5_WLDS = 14592;
__device__ __forceinline__ void s5_bu_tile(lp_t wlds, const S5W& W, const u32x2 av, int fr, int fq) {
    const bf16x4 a = __builtin_bit_cast(bf16x4, av);
#pragma unroll
    for (int nt = 0; nt < 4; ++nt) {
        f32x4 c = __builtin_amdgcn_mfma_f32_16x16x16bf16_1k(a, W.bre[nt], (f32x4){0.f, 0.f, 0.f, 0.f}, 0, 0, 0);
        *(LAS f32x4*)(wlds + S5_BUT + (16 * nt + fr) * S5_LDB + fq * 16) = c;
        c = __builtin_amdgcn_mfma_f32_16x16x16bf16_1k(a, W.bim[nt], (f32x4){0.f, 0.f, 0.f, 0.f}, 0, 0, 0);
        *(LAS f32x4*)(wlds + S5_BUT + (64 + 16 * nt + fr) * S5_LDB + fq * 16) = c;
    }
}
__device__ __forceinline__ void s5_pass_a(lp_t wlds, int v, const bf16_t* U, float* E, const float* a_re, const float* a_im, const float* log_dt, const float* b_re, const float* b_im, int lane) {
    asm volatile("" : "+v"(lane));
    const int seg = v & (NSEG - 1), g = (v >> 5) & 31, b = v >> 10, fr = lane & 15, fq = lane >> 4;
    S5W W; s5_setup(W, g, lane, a_re, a_im, log_dt, b_re, b_im);
    float xr = 0.f, xi = 0.f;
    const size_t row0 = (size_t)b * SEQ + (size_t)seg * LSEG;
    u32x2 avn = *(const u32x2*)(U + (row0 + fr) * 512 + g * 16 + 4 * fq);
#pragma unroll 1
    for (int tile = 0; tile < LSEG / 16; ++tile) {
        const u32x2 av = avn; { const size_t rn = row0 + (tile + 1 < LSEG / 16 ? tile + 1 : tile) * 16; avn = *(const u32x2*)(U + (rn + fr) * 512 + g * 16 + 4 * fq); }
        s5_bu_tile(wlds, W, av, fr, fq);
        LDS_WAIT(); asm volatile("" ::: "memory");
        f32x4 re[4], im[4];
#pragma unroll
        for (int q = 0; q < 4; ++q) { re[q] = *(const LAS f32x4*)(wlds + S5_BUT + lane * S5_LDB + q * 16); im[q] = *(const LAS f32x4*)(wlds + S5_BUT + (64 + lane) * S5_LDB + q * 16); }
#pragma unroll
        for (int tt = 0; tt < 16; ++tt) { const float nr = W.are * xr - W.aim * xi + re[tt >> 2][tt & 3], ni = W.are * xi + W.aim * xr + im[tt >> 2][tt & 3]; xr = nr; xi = ni; }
        LDS_WAIT(); asm volatile("" ::: "memory");
    }
    *(f32x2*)(E + ((size_t)v * 64 + lane) * 2) = (f32x2){xr, xi};
}
__device__ __forceinline__ void s5_pass_b(lp_t wlds, int v, const bf16_t* U, const float* E, const float* a_re, const float* a_im, const float* log_dt, const float* b_re, const float* b_im,
                                          const float* c_re, const float* c_im, const float* dvec, bf16_t* YS, int lane) {
    asm volatile("" : "+v"(lane));
    const int seg = v & (NSEG - 1), g = (v >> 5) & 31, b = v >> 10, fr = lane & 15, fq = lane >> 4;
    S5W W; s5_setup(W, g, lane, a_re, a_im, log_dt, b_re, b_im);
    float pr = W.are, pi = W.aim;
#pragma unroll
    for (int s = 0; s < 8; ++s) { const float nr = pr * pr - pi * pi, ni = 2.0f * pr * pi; pr = nr; pi = ni; }
    float xr = 0.f, xi = 0.f;
#pragma unroll 1
    for (int s0 = 0; s0 < seg; s0 += 8) {
        f32x2 e[8];
#pragma unroll
        for (int k = 0; k < 8; ++k) { const int sk = (s0 + k < seg) ? s0 + k : seg - 1; e[k] = *(const f32x2*)(E + ((size_t)(v - seg + sk) * 64 + lane) * 2); }
#pragma unroll
        for (int k = 0; k < 8; ++k) if (s0 + k < seg) { const float nr = pr * xr - pi * xi + e[k][0], ni = pr * xi + pi * xr + e[k][1]; xr = nr; xi = ni; }
    }
    bf16x8 cb[4];
#pragma unroll
    for (int kt = 0; kt < 4; ++kt) { const float* src = (kt < 2 ? c_re : c_im) + (size_t)(g * 16 + fr) * 64 + 32 * (kt & 1) + 8 * fq; const float sg = kt < 2 ? 1.f : -1.f;
        const f32x4 v0 = *(const f32x4*)src, v1 = *(const f32x4*)(src + 4); u32x4 w; w.x = cvt_pk_bf16(sg * v0[0], sg * v0[1]); w.y = cvt_pk_bf16(sg * v0[2], sg * v0[3]); w.z = cvt_pk_bf16(sg * v1[0], sg * v1[1]); w.w = cvt_pk_bf16(sg * v1[2], sg * v1[3]);
        cb[kt] = __builtin_bit_cast(bf16x8, w); }
    const float dco = dvec[g * 16 + fr];
    const lp_t xt = wlds + S5_XT;
    const size_t row0 = (size_t)b * SEQ + (size_t)seg * LSEG;
    u32x2 avn = *(const u32x2*)(U + (row0 + fr) * 512 + g * 16 + 4 * fq); unsigned short uvn[4];
#pragma unroll
    for (int j = 0; j < 4; ++j) uvn[j] = U[(row0 + 4 * fq + j) * 512 + g * 16 + fr];
#pragma unroll 1
    for (int tile = 0; tile < LSEG / 16; ++tile) {
        const size_t r0 = row0 + tile * 16;
        const u32x2 av = avn; float uv[4];
#pragma unroll
        for (int j = 0; j < 4; ++j) uv[j] = bf2f(uvn[j]);
        { const size_t rn = row0 + (tile + 1 < LSEG / 16 ? tile + 1 : tile) * 16; avn = *(const u32x2*)(U + (rn + fr) * 512 + g * 16 + 4 * fq);
#pragma unroll
          for (int j = 0; j < 4; ++j) uvn[j] = U[(rn + 4 * fq + j) * 512 + g * 16 + fr]; }
        s5_bu_tile(wlds, W, av, fr, fq);
        LDS_WAIT(); asm volatile("" ::: "memory");
        f32x4 re[4], im[4];
#pragma unroll
        for (int q = 0; q < 4; ++q) { re[q] = *(const LAS f32x4*)(wlds + S5_BUT + lane * S5_LDB + q * 16); im[q] = *(const LAS f32x4*)(wlds + S5_BUT + (64 + lane) * S5_LDB + q * 16); }
#pragma unroll
        for (int tt = 0; tt < 16; ++tt) { const float nr = W.are * xr - W.aim * xi + re[tt >> 2][tt & 3], ni = W.are * xi + W.aim * xr + im[tt >> 2][tt & 3]; xr = nr; xi = ni;
            *(LAS unsigned short*)(xt + tt * LD136 + lane * 2) = f2bf(xr); *(LAS unsigned short*)(xt + tt * LD136 + (64 + lane) * 2) = f2bf(xi); }
        LDS_WAIT(); asm volatile("" ::: "memory");
        f32x4 acc = (f32x4){0.f, 0.f, 0.f, 0.f};
#pragma unroll
        for (int kt = 0; kt < 4; ++kt) { const bf16x8 a = *(const LAS bf16x8*)(xt + fr * LD136 + (32 * kt + 8 * fq) * 2); acc = __builtin_amdgcn_mfma_f32_16x16x32_bf16(a, cb[kt], acc, 0, 0, 0); }
#pragma unroll
        for (int j = 0; j < 4; ++j) YS[(r0 + 4 * fq + j) * 512 + g * 16 + fr] = f2bf(gelu_tanh(acc[j] + dco * uv[j]));
        LDS_WAIT(); asm volatile("" ::: "memory");
    }
}

#define XB_TMO      128
#define XB_XCNT(j)  (256  + 64 * (j))
#define XB_XSUB(j)  (1280 + 64 * (j))
#define XB_XGEN(j)  (2304 + 64 * (j))
#define XB_TOP      3328
#define XB_TOPGEN   3392
#define XCD_BAR_WORDS 3456
#define XB_SPIN_CAP (1u << 22)
__device__ __forceinline__ unsigned xb_ld(unsigned* p)              { return __hip_atomic_load(p, __ATOMIC_RELAXED, __HIP_MEMORY_SCOPE_AGENT); }
__device__ __forceinline__ unsigned xb_add(unsigned* p, unsigned v) { return __hip_atomic_fetch_add(p, v, __ATOMIC_RELAXED, __HIP_MEMORY_SCOPE_AGENT); }
__device__ __forceinline__ unsigned xb_xcc_id() { return (unsigned)__builtin_amdgcn_s_getreg((3 << 11) | 20) & 0xFu; }
#define XB_SPIN(cond, bar) do { unsigned _sp = 0; while (cond) { __builtin_amdgcn_s_sleep(1); \
    if ((++_sp & 255u) == 0u) { if (xb_ld(&(bar)[XB_TMO])) break; if (_sp > XB_SPIN_CAP) { atomicAdd(&(bar)[XB_TMO], 1u); break; } } } } while (0)
struct XcdBarrier { unsigned* bar; unsigned x; volatile LAS unsigned* st; };
__device__ __forceinline__ XcdBarrier xcd_barrier_post(unsigned* bar, volatile LAS unsigned* st) {
    XcdBarrier b; b.bar = bar; b.x = xb_xcc_id(); b.st = st;
    if (threadIdx.x == 0) (void)xb_add(&bar[XB_XCNT(b.x)], 1u);
    return b;
}
__device__ __forceinline__ void xcd_barrier_complete(unsigned* bar, unsigned x, unsigned& nloc, unsigned& nx) {
    const unsigned G = gridDim.x * gridDim.y * gridDim.z;
    unsigned sum, cnt, mine, sp = 0u;
    for (;;) {
        sum = 0u; cnt = 0u; mine = 0u;
#pragma unroll
        for (unsigned j = 0; j < 16; ++j) { const unsigned c = xb_ld(&bar[XB_XCNT(j)]); sum += c; cnt += (c > 0u) ? 1u : 0u; mine = (j == x) ? c : mine; }
        if (sum == G) break;
        __builtin_amdgcn_s_sleep(1);
        if ((++sp & 255u) == 0u) { if (xb_ld(&bar[XB_TMO])) break; if (sp > XB_SPIN_CAP) { atomicAdd(&bar[XB_TMO], 1u); break; } }
    }
    nloc = mine > 0u ? mine : 1u; nx = cnt > 0u ? cnt : 1u;
}
__device__ __forceinline__ void xcd_barrier(const XcdBarrier& b) {
    asm volatile("s_waitcnt vmcnt(0) lgkmcnt(0)" ::: "memory");
    __syncthreads();
    if (threadIdx.x == 0) {
        unsigned* bar = b.bar;
        __builtin_amdgcn_s_waitcnt(0);
        unsigned nloc = b.st[0], nx = b.st[1];
        if (nloc == 0u) { xcd_barrier_complete(bar, b.x, nloc, nx); b.st[0] = nloc; b.st[1] = nx; }
        const unsigned old = xb_add(&bar[XB_XSUB(b.x)], 1u);
        const unsigned gen = old / nloc;
        if (old + 1u == (gen + 1u) * nloc) {
            __builtin_amdgcn_fence(__ATOMIC_RELEASE, "agent");
            asm volatile("s_waitcnt vmcnt(0)" ::: "memory");
            const unsigned og = xb_add(&bar[XB_TOP], 1u);
            const unsigned tg = og / nx;
            if (og + 1u == (tg + 1u) * nx) xb_add(&bar[XB_TOPGEN], 1u);
            else XB_SPIN(xb_ld(&bar[XB_TOPGEN]) == tg, bar);
            __builtin_amdgcn_fence(__ATOMIC_ACQUIRE, "agent");
            xb_add(&bar[XB_XGEN(b.x)], 1u);
            asm volatile("s_waitcnt vmcnt(0)" ::: "memory");
        } else {
            XB_SPIN(xb_ld(&bar[XB_XGEN(b.x)]) == gen, bar);
            __builtin_amdgcn_fence(__ATOMIC_ACQUIRE, "agent");
            asm volatile("s_waitcnt vmcnt(0)" ::: "memory");
        }
    }
    __syncthreads();
}

__global__ void __launch_bounds__(512, 2) hybrid_fwd(Args args) {
    extern __shared__ __attribute__((aligned(16))) unsigned char lds_raw[];
    cg::grid_group grid = cg::this_grid();
    const lp_t lds = (lp_t)lds_raw;
    const int tid = threadIdx.x, lane = tid & 63, wave = __builtin_amdgcn_readfirstlane(tid >> 6);
    const int G = gridDim.x, bx = blockIdx.x, gw = bx * 8 + wave, NGW = G * 8;
    typedef const __attribute__((address_space(4))) Args* kargp_t;
    const kargp_t kp0 = (kargp_t)__builtin_amdgcn_kernarg_segment_ptr();
#define ARGS() ({ kargp_t p_ = kp0; asm volatile("" : "+s"(p_)); p_; })
    unsigned char* ws = ARGS()->ws;
    float* MOD = (float*)(ws + WS_MOD); float* PART = (float*)(ws + WS_PART);
    bf16_t* H = (bf16_t*)(ws + WS_H); bf16_t* HID = (bf16_t*)(ws + WS_BIG); bf16_t* YR = (bf16_t*)(ws + WS_YR);
    {
        if (tid < 16) ((LAS unsigned*)(lds + LDS_BYTES - 64))[tid] = 0u;
        __syncthreads();
    }
    XcdBarrier xbar = xcd_barrier_post((unsigned*)(ws + WS_CTL), (volatile LAS unsigned*)(lds + LDS_BYTES - 64));
    grid.sync();
#define GSYNC() xcd_barrier(xbar)

    {
        LAS float* scr = (LAS float*)(lds + wave * 8704);
        constexpr int I_FFI = 16 * 176, I_FFO = 44 * 32, I_MXI = 16 * 88, I_GLU = 8 * 16, I_MXO = 16 * 32;
        constexpr int I_LAYER = 2 * I_FFI + 2 * I_FFO + I_MXI + I_GLU + I_MXO;
        for (int it = gw; it < DEPTH * I_LAYER; it += NGW) {
            const int l = it / I_LAYER; int r = it % I_LAYER; bf16_t* wl = (bf16_t*)(ws + WS_W + (size_t)l * W_LAYER);
            if (r < I_FFI) { transpose_item(ARGS()->in[6] + (size_t)l * DM * 2 * DFF, DM, 2 * DFF, (bf16_t*)((char*)wl + WO_FF1_IN), scr, r / 176, r % 176, 1, lane); continue; } r -= I_FFI;
            if (r < I_FFO) { transpose_item(ARGS()->in[7] + (size_t)l * DFF * DM, DFF, DM, (bf16_t*)((char*)wl + WO_FF1_OUT), scr, r / 32, r % 32, 0, lane); continue; } r -= I_FFO;
            if (r < I_MXI) { transpose_item(ARGS()->in[10] + (size_t)l * DM * PROJ_W, DM, PROJ_W, (bf16_t*)((char*)wl + WO_MIX_IN), scr, r / 88, r % 88, 2, lane); continue; } r -= I_MXI;
            if (r < I_GLU) { transpose_item(ARGS()->in[23] + (size_t)l * 512 * 512, 512, 512, (bf16_t*)((char*)wl + WO_GLU), scr, r / 16, r % 16, 0, lane); continue; } r -= I_GLU;
            if (r < I_MXO) { transpose_item(ARGS()->in[24] + (size_t)l * DM * DM, DM, DM, (bf16_t*)((char*)wl + WO_MIX_OUT), scr, r / 32, r % 32, 0, lane); continue; } r -= I_MXO;
            if (r < I_FFI) { transpose_item(ARGS()->in[27] + (size_t)l * DM * 2 * DFF, DM, 2 * DFF, (bf16_t*)((char*)wl + WO_FF2_IN), scr, r / 176, r % 176, 1, lane); continue; } r -= I_FFI;
            transpose_item(ARGS()->in[28] + (size_t)l * DFF * DM, DFF, DM, (bf16_t*)((char*)wl + WO_FF2_OUT), scr, r / 32, r % 32, 0, lane);
        }
        __syncthreads();
        LAS float* ca = (LAS float*)lds; LAS float* red = (LAS float*)(lds + 16384);
        for (int i = tid; i < NB * DM; i += 512) { const float v = ARGS()->in[1][i]; ca[i] = v / (1.0f + expf(-v)); }
        __syncthreads();
        for (int it = bx; it < DEPTH * (NMOD / 64); it += G) {
            const int l = it / (NMOD / 64), cb = it % (NMOD / 64), col = cb * 64 + lane;
            const float* wm = ARGS()->in[2] + (size_t)l * DM * NMOD + col;
            float a0 = 0.f, a1 = 0.f, a2 = 0.f, a3 = 0.f;
#pragma unroll 8
            for (int k = wave * 128; k < wave * 128 + 128; ++k) { const float w = wm[(size_t)k * NMOD]; a0 += ca[k] * w; a1 += ca[DM + k] * w; a2 += ca[2 * DM + k] * w; a3 += ca[3 * DM + k] * w; }
            red[(wave * 4 + 0) * 64 + lane] = a0; red[(wave * 4 + 1) * 64 + lane] = a1; red[(wave * 4 + 2) * 64 + lane] = a2; red[(wave * 4 + 3) * 64 + lane] = a3;
            __syncthreads();
            if (tid < 256) { const int b = tid >> 6; float s = ARGS()->in[3][(size_t)l * NMOD + col];
#pragma unroll
                for (int w = 0; w < 8; ++w) s += red[(w * 4 + b) * 64 + lane];
                MOD[((size_t)l * NB + b) * NMOD + col] = s; }
            __syncthreads();
        }
    }
    GSYNC();
    finalize_phase(ARGS()->in[0], nullptr, nullptr, nullptr, nullptr, 0.f, nullptr, ARGS()->in[4], MOD + 0 * DM, MOD + 1 * DM, H, gw, NGW, lane);
    GSYNC();

#pragma unroll 1
    for (int l = 0; l < DEPTH; ++l) {
        const unsigned char* wl = ws + WS_W + (size_t)l * W_LAYER;
        const float* modl = MOD + (size_t)l * NB * NMOD;
#pragma unroll 1
        for (int sub = 0; sub < 3; ++sub) {
#ifdef SKIP_MIX
            if (sub == 1) continue;
#endif
            if (sub != 1) {
                { pg8::Gemm g{H, (const bf16_t*)(wl + (sub == 0 ? WO_FF1_IN : WO_FF2_IN)), M, 2 * DFF, DM, DM, DM}; pg8::StaticOrder S; S.init(M, 2 * DFF, G, bx);
                  EpiSwiglu E{HID, DFF};
#pragma unroll 1
                  for (int rep = 0; rep < ARGS()->rep_a; ++rep) { pg8::gemm_phase<EpiSwiglu, true>(lds, g, S, E); __syncthreads(); }
 }
                GSYNC();
                { pg8::Gemm g{HID, (const bf16_t*)(wl + (sub == 0 ? WO_FF1_OUT : WO_FF2_OUT)), M, DM, DFF, DFF, DFF}; pg8::StaticOrder S; S.init(M, DM, G, bx);
                  EpiYraw E{YR, PART};
#pragma unroll 1
                  for (int rep = 0; rep < ARGS()->rep_a; ++rep) { pg8::gemm_phase<EpiYraw, true>(lds, g, S, E); __syncthreads(); }
 }
                GSYNC();
            } else {
                bf16_t* QKV = (bf16_t*)(ws + WS_QKV); bf16_t* Zb = (bf16_t*)(ws + WS_Z); bf16_t* Ub = (bf16_t*)(ws + WS_U);
                float* BETA = (float*)(ws + WS_BETA); float* Gg = (float*)(ws + WS_G); float* EGL = (float*)(ws + WS_EGL); float* S5E = (float*)(ws + WS_S5E);
                bf16_t* Dg = (bf16_t*)(ws + WS_D); bf16_t* RTg = (bf16_t*)(ws + WS_RT); bf16_t* QPg = (bf16_t*)(ws + WS_QP); bf16_t* O0Tg = (bf16_t*)(ws + WS_O0T);
                bf16_t* SCg = (bf16_t*)(ws + WS_SC); bf16_t* YS = (bf16_t*)(ws + WS_YS); bf16_t* YCAT = (bf16_t*)(ws + WS_YCAT);
                { pg8::Gemm g{H, (const bf16_t*)(wl + WO_MIX_IN), M, MIXN, DM, DM, DM}; pg8::StaticOrder S; S.init(M, MIXN, G, bx);
                  EpiInproj E{QKV, Zb, Ub, BETA, Gg, ARGS()->in[12] + l * 4, ARGS()->in[13] + l * 4};
#ifndef SKIP_GI1
pg8::gemm_phase<EpiInproj, true>(lds, g, S, E);
#endif
 }
                GSYNC();

#pragma unroll 1
                for (int rep = 0; rep < ARGS()->rep_b; ++rep)
                for (int u = bx; u < NUNIT; u += G) gdn_pre_unit(lds, u, QKV, ARGS()->in[11] + (size_t)l * 4 * 1536, BETA, Gg, Dg, RTg, QPg, O0Tg, EGL);

                __syncthreads();

#ifndef SKIP_S5A
                for (int v = gw; v < NB * S5G * NSEG; v += NGW)
                    s5_pass_a(lds + wave * S5_WLDS, v, Ub, S5E, ARGS()->in[15] + l * 2048, ARGS()->in[16] + l * 2048, ARGS()->in[17] + l * 32, ARGS()->in[18] + (size_t)l * 32768, ARGS()->in[19] + (size_t)l * 32768, lane);
#endif

                GSYNC();

#pragma unroll 1
                for (int rep = 0; rep < ARGS()->rep_c; ++rep) {
                if (bx < 32) gdn_scan(lds, bx, Dg, RTg, EGL, SCg);


#ifndef SKIP_S5B
                if (bx >= 32) for (int v = (bx - 32) * 8 + wave; v < NB * S5G * NSEG; v += (G - 32) * 8)
                    s5_pass_b(lds + wave * S5_WLDS, v, Ub, S5E, ARGS()->in[15] + l * 2048, ARGS()->in[16] + l * 2048, ARGS()->in[17] + l * 32, ARGS()->in[18] + (size_t)l * 32768, ARGS()->in[19] + (size_t)l * 32768,
                              ARGS()->in[20] + (size_t)l * 32768, ARGS()->in[21] + (size_t)l * 32768, ARGS()->in[22] + l * 512, YS, lane);
#endif
                }

                GSYNC();

#ifndef SKIP_OUT
                for (int p = bx; p < NUNIT / 2; p += G) gdn_out_pair(p, QPg, O0Tg, SCg, Zb, ARGS()->in[14] + l * HD, YCAT);
#endif

                { pg8::Gemm g{YS, (const bf16_t*)(wl + WO_GLU), M, 512, 512, 512, 512}; pg8::StaticOrder S; S.init(M, 512, G, bx);
                  EpiGlu E{YS, YCAT};
#ifndef SKIP_GG1
pg8::gemm_phase<EpiGlu, true>(lds, g, S, E);
#endif
 }
                GSYNC();
                { pg8::Gemm g{YCAT, (const bf16_t*)(wl + WO_MIX_OUT), M, DM, DM, DM, DM}; pg8::StaticOrder S; S.init(M, DM, G, bx);
                  EpiYraw E{YR, PART};
#ifndef SKIP_GY2
pg8::gemm_phase<EpiYraw, true>(lds, g, S, E);
#endif
 }
                GSYNC();
            }
            {
                const float* xsrc = (l == 0 && sub == 0) ? ARGS()->in[0] : ARGS()->out;
                const float* wpost = (sub == 0 ? ARGS()->in[5] : (sub == 1 ? ARGS()->in[9] : ARGS()->in[26])) + l * DM;
                const float* gate = modl + (3 * sub + 2) * DM; const float gs = sub == 1 ? 1.0f : 0.5f;
                const bool last = (l == DEPTH - 1 && sub == 2);
                const int nl = sub == 2 ? l + 1 : l, nsub = sub == 2 ? 0 : sub + 1;
                const float* wpre = last ? nullptr : (nsub == 0 ? ARGS()->in[4] : (nsub == 1 ? ARGS()->in[8] : ARGS()->in[25])) + nl * DM;
                const float* modn = MOD + (size_t)(last ? 0 : nl) * NB * NMOD;
                finalize_phase(xsrc, ARGS()->out, YR, PART, gate, gs, wpost, wpre, modn + (3 * nsub) * DM, modn + (3 * nsub + 1) * DM, last ? nullptr : H, gw, NGW, lane);
            }
            GSYNC();
        }
    }
}

extern "C" void kernel_launch(void* const* d_in, const int* in_sizes, int n_in, void* d_out, int out_size, void* d_ws, size_t ws_size, hipStream_t stream) {
    static int grid = 0;
    if (grid == 0) {
        if (n_in != 29 || ws_size < WS_END) { fprintf(stderr, "kernel_launch: unexpected n_in %d or ws %zu\n", n_in, ws_size); grid = -1; return; }
        int dev = 0, cus = 0, per_cu = 0;
        hipGetDevice(&dev); hipDeviceGetAttribute(&cus, hipDeviceAttributeMultiprocessorCount, dev);
        hipFuncSetAttribute((const void*)hybrid_fwd, hipFuncAttributeMaxDynamicSharedMemorySize, LDS_BYTES);
        hipOccupancyMaxActiveBlocksPerMultiprocessor(&per_cu, (const void*)hybrid_fwd, 512, LDS_BYTES);
        if (per_cu < 1) { fprintf(stderr, "kernel_launch: occupancy query says %d blocks per CU\n", per_cu); per_cu = 1; }
        (void)hipGetLastError();
        grid = cus * 1;
    }
    if (grid < 0) return;
    if (hipMemsetAsync((char*)d_ws + WS_CTL, 0, CTL_BYTES, stream) != hipSuccess) { fprintf(stderr, "memset failed\n"); return; }
    Args a{};
    for (int i = 0; i < 29; ++i) a.in[i] = (const float*)d_in[i];
    a.out = (float*)d_out; a.ws = (unsigned char*)d_ws; a.rep_a = REP_A; a.rep_b = REP_B; a.rep_c = REP_C; a.pad = 0;
    void* kargs[] = {&a};
    hipError_t e = hipLaunchCooperativeKernel((const void*)hybrid_fwd, dim3(grid), dim3(512), kargs, LDS_BYTES, stream);
    if (e != hipSuccess) fprintf(stderr, "cooperative launch failed: %s (grid %d)\n", hipGetErrorString(e), grid);
}
```

```cpp
#include <hip/hip_runtime.h>
#include <hip/hip_cooperative_groups.h>
#include <cstdio>
#include <cstdint>
namespace cg = cooperative_groups;

#define LAS __attribute__((address_space(3)))
typedef unsigned short bf16_t;
typedef short bf16x8 __attribute__((ext_vector_type(8)));
typedef float f32x4 __attribute__((ext_vector_type(4)));
typedef float f32x2 __attribute__((ext_vector_type(2)));
typedef unsigned u32x4 __attribute__((ext_vector_type(4)));
typedef unsigned u32x2 __attribute__((ext_vector_type(2)));
typedef LAS unsigned char* lp_t;

constexpr int DM = 1024, NB = 4, SEQ = 8192, M = NB * SEQ, DEPTH = 2;
constexpr int DFF = 2816, NH = 4, HD = 128, CH = 64, NCH = SEQ / CH;
constexpr int NUNIT = NB * NH * NCH;
constexpr int S5G = 32, S5P = 64, S5H = 16, LSEG = 256, NSEG = SEQ / LSEG;
constexpr int NMOD = 9 * DM;
constexpr int PROJ_W = 2568, MIXN = 2816;
constexpr float EPS = 1e-6f;

namespace pg8 {
constexpr int BM = 256, BK = 64, HALF = 128, HTB = HALF * BK * 2, STAGE_BYTES = 8 * HTB, NXCD = 8, WGM = 8;
__device__ __forceinline__ int lds_byte(int r, int c) { const int st = (r >> 4) * 2 + (c >> 5), rr = r & 15, cc = c & 31, ob = rr * 64 + cc * 2; return st * 1024 + (ob ^ (((ob >> 9) & 1) << 5)); }
__device__ __forceinline__ void stage_rc(int b, int& R, int& C) { const int st = b / 1024, sb = b % 1024, swz = sb ^ (((sb >> 9) & 1) << 5); R = (st >> 1) * 16 + swz / 64; C = (st & 1) * 32 + (swz % 64) / 2; }
__device__ __forceinline__ int perm32(int rho) { const int n = rho >> 4, i = rho & 15; return 8 * (i >> 2) + 4 * n + (i & 3); }
struct Unit { int pm, pn; };
struct Gemm { const bf16_t* A; const bf16_t* Bt; int M, N, K, lda, ldb; };
struct StaticOrder {
    int nM, nN, nwg, G, c;
    __device__ void init(int M_, int N_, int G_, int c_) { nM = M_ / BM; nN = N_ / BM; nwg = nM * nN; G = G_; c = c_; }
    __device__ bool next(int i, Unit& u) const {
        const long L = (long)i * G + c; if (L >= nwg) return false;
        int wgid = (int)L; { const int q = nwg / NXCD, r = nwg % NXCD, xcd = wgid % NXCD, off = wgid / NXCD; wgid = (xcd < r ? xcd * (q + 1) : r * (q + 1) + (xcd - r) * q) + off; }
        const int nig = WGM * nN, gid = wgid / nig, fm = gid * WGM, gsz = (nM - fm) < WGM ? (nM - fm) : WGM;
        u.pm = fm + ((wgid % nig) % gsz); u.pn = (wgid % nig) / gsz; return true;
    }
};
typedef __bf16 bf16x2_t __attribute__((ext_vector_type(2)));
__device__ __forceinline__ unsigned cvt_pk_bf16(float lo, float hi) { f32x2 v = {lo, hi}; bf16x2_t b = __builtin_convertvector(v, bf16x2_t); return __builtin_bit_cast(unsigned, b); }

template <class Epi, bool ALIGN_EPI>
__device__ __forceinline__ void gemm_phase(lp_t lds, const Gemm g, const StaticOrder& S, const Epi& E) {
    int tid_ = threadIdx.x; asm volatile("" : "+v"(tid_));
    const int tid = tid_, wid = __builtin_amdgcn_readfirstlane(tid >> 6), lane = tid & 63, wr = wid >> 2, wc = wid & 3, fr = lane & 15, fq = lane >> 4;
    const int K = g.K, nt = K / BK;
    unsigned voffA[2], voffB[2];
#pragma unroll
    for (int i = 0; i < 2; ++i) { int R, C; stage_rc(tid * 16 + i * 8192, R, C); const int Rb = Epi::PERM ? ((R & ~31) + perm32(R & 31)) : R;
        voffA[i] = (unsigned)(R * g.lda + C) * 2u; voffB[i] = (unsigned)(Rb * g.ldb + C) * 2u; }
    const size_t kstep = (size_t)(BK * 2);
    const size_t hsA = (size_t)HALF * g.lda * 2, hsB = (size_t)HALF * g.ldb * 2, tsA = 2 * hsA, tsB = 2 * hsB;
    const unsigned ldsw = (unsigned)wid * 1024u;
    const int aoff = lds_byte(wr * 64 + fr, fq * 8), boff = lds_byte(wc * 32 + fr, fq * 8);
#define PG8_SA(b, h) (((b) * 2 + (h)) * HTB)
#define PG8_SB(b, h) ((4 + (b) * 2 + (h)) * HTB)
#define PG8_STAGE(bufoff, gbase, voff) do { _Pragma("unroll") for (int _i = 0; _i < 2; ++_i) \
        __builtin_amdgcn_global_load_lds((const unsigned*)((const char*)(gbase) + (voff)[_i]), (LAS unsigned*)(lds + (bufoff) + ldsw + _i * 8192), 16, 0, 0); } while (0)
#define PG8_LDA(dst, b, h) do { _Pragma("unroll") for (int m = 0; m < 4; ++m) _Pragma("unroll") for (int k = 0; k < 2; ++k) dst[m][k] = *(const LAS bf16x8*)(lds + PG8_SA(b, h) + aoff + m * 2048 + k * 1024); } while (0)
#define PG8_LDB(dst, b, h) do { _Pragma("unroll") for (int n = 0; n < 2; ++n) _Pragma("unroll") for (int k = 0; k < 2; ++k) dst[n][k] = *(const LAS bf16x8*)(lds + PG8_SB(b, h) + boff + n * 2048 + k * 1024); } while (0)
#define PG8_MMA(ai, bj, At, Bt) do { __builtin_amdgcn_s_setprio(1); _Pragma("unroll") for (int m = 0; m < 4; ++m) _Pragma("unroll") for (int n = 0; n < 2; ++n) _Pragma("unroll") for (int k = 0; k < 2; ++k) \
        acc[ai][bj][m][n] = __builtin_amdgcn_mfma_f32_16x16x32_bf16(Bt[n][k], At[m][k], acc[ai][bj][m][n], 0, 0, 0); __builtin_amdgcn_s_setprio(0); } while (0)
#define PG8_WAIT_V(n) asm volatile("s_waitcnt vmcnt(" #n ")" ::: "memory")
#define PG8_WAIT_L(n) asm volatile("s_waitcnt lgkmcnt(" #n ")" ::: "memory")
#define PG8_BAR __builtin_amdgcn_s_barrier()
#define PG8_SCHED __builtin_amdgcn_sched_barrier(0)
    Unit cur, nxt; int ui = 0;
    if (!S.next(0, cur)) return;
    f32x4 acc[2][2][4][2];
#pragma unroll
    for (int a = 0; a < 2; ++a)
#pragma unroll
        for (int b = 0; b < 2; ++b)
#pragma unroll
            for (int m = 0; m < 4; ++m)
#pragma unroll
                for (int n = 0; n < 2; ++n) acc[a][b][m][n] = (f32x4){0.f, 0.f, 0.f, 0.f};
    bf16x8 At[4][2], B0[2][2], B1[2][2];
    const char* cA = (const char*)g.A + (size_t)cur.pm * tsA; const char* cB = (const char*)g.Bt + (size_t)cur.pn * tsB;
    PG8_STAGE(PG8_SB(0, 0), cB, voffB); PG8_STAGE(PG8_SB(0, 1), cB + hsB, voffB); PG8_STAGE(PG8_SA(0, 0), cA, voffA); PG8_STAGE(PG8_SA(0, 1), cA + hsA, voffA);
    if (wr == 1) PG8_BAR;
    PG8_WAIT_V(2); PG8_BAR;
    PG8_STAGE(PG8_SB(1, 0), cB + kstep, voffB); PG8_STAGE(PG8_SA(1, 0), cA + kstep, voffA); PG8_STAGE(PG8_SB(1, 1), cB + hsB + kstep, voffB);
    PG8_WAIT_V(6); PG8_BAR;
    for (;;) {
        const bool has_next = S.next(ui + 1, nxt);
        const char* nA = has_next ? (const char*)g.A + (size_t)nxt.pm * tsA : cA; const char* nB = has_next ? (const char*)g.Bt + (size_t)nxt.pn * tsB : cB;
        for (int t = 0; t < nt; t += 2) {
            const bool last = (t == nt - 2);
            const char* a1 = cA + (size_t)(t + 1) * kstep;
            const char* a2 = last ? nA : cA + (size_t)(t + 2) * kstep; const char* b2 = last ? nB : cB + (size_t)(t + 2) * kstep;
            const char* a3 = a2 + kstep; const char* b3 = b2 + kstep;
            PG8_LDB(B0, 0, 0); PG8_LDB(B1, 0, 1); PG8_SCHED; PG8_LDA(At, 0, 0); PG8_STAGE(PG8_SA(1, 1), a1 + hsA, voffA);
            PG8_WAIT_V(8); PG8_WAIT_L(0); PG8_BAR; PG8_MMA(0, 0, At, B0); PG8_MMA(0, 1, At, B1); PG8_BAR; PG8_SCHED;
            PG8_LDA(At, 0, 1); PG8_STAGE(PG8_SB(0, 0), b2, voffB); PG8_STAGE(PG8_SB(0, 1), b2 + hsB, voffB); PG8_STAGE(PG8_SA(0, 0), a2, voffA);
            PG8_WAIT_V(8); PG8_WAIT_L(0); PG8_BAR; PG8_MMA(1, 0, At, B0); PG8_MMA(1, 1, At, B1); PG8_BAR; PG8_SCHED;
            PG8_LDB(B0, 1, 0); PG8_LDB(B1, 1, 1); PG8_SCHED; PG8_LDA(At, 1, 0); PG8_STAGE(PG8_SA(0, 1), a2 + hsA, voffA);
            PG8_WAIT_V(8); PG8_WAIT_L(0); PG8_BAR; PG8_MMA(0, 0, At, B0); PG8_MMA(0, 1, At, B1); PG8_BAR; PG8_SCHED;
            PG8_LDA(At, 1, 1); PG8_STAGE(PG8_SB(1, 0), b3, voffB); PG8_STAGE(PG8_SB(1, 1), b3 + hsB, voffB); PG8_STAGE(PG8_SA(1, 0), a3, voffA);
            PG8_WAIT_V(8); PG8_WAIT_L(0); PG8_BAR; PG8_MMA(1, 0, At, B0); PG8_MMA(1, 1, At, B1); PG8_BAR; PG8_SCHED;
        }
        if constexpr (ALIGN_EPI) { if (wr == 0) PG8_BAR; }
        E(acc, cur, wr, wc, fr, fq);
        if (!has_next) break;
#pragma unroll
        for (int a = 0; a < 2; ++a)
#pragma unroll
            for (int b = 0; b < 2; ++b)
#pragma unroll
                for (int m = 0; m < 4; ++m)
#pragma unroll
                    for (int n = 0; n < 2; ++n) acc[a][b][m][n] = (f32x4){0.f, 0.f, 0.f, 0.f};
        cur = nxt; cA = nA; cB = nB; ++ui;
        if constexpr (ALIGN_EPI) { if (wr == 1) PG8_BAR; }
    }
    PG8_WAIT_V(0);
    if constexpr (!ALIGN_EPI) { if (wr == 0) PG8_BAR; }
    PG8_BAR;
#undef PG8_SA
#undef PG8_SB
#undef PG8_STAGE
#undef PG8_LDA
#undef PG8_LDB
#undef PG8_MMA
#undef PG8_WAIT_V
#undef PG8_WAIT_L
#undef PG8_BAR
#undef PG8_SCHED
}
}
using pg8::cvt_pk_bf16;

__device__ __forceinline__ float bf2f(unsigned v) { return __uint_as_float(v << 16); }
__device__ __forceinline__ float bflo(unsigned w) { return __uint_as_float(w << 16); }
__device__ __forceinline__ float bfhi(unsigned w) { return __uint_as_float(w & 0xffff0000u); }
__device__ __forceinline__ unsigned short f2bf(float f) { return (unsigned short)(cvt_pk_bf16(f, 0.f) & 0xffffu); }
__device__ __forceinline__ float sigmoidf_(float x) { return 1.0f / (1.0f + __expf(-x)); }
__device__ __forceinline__ float siluf_(float x) { return x * sigmoidf_(x); }
__device__ __forceinline__ float gelu_tanh(float y) { const float z = 0.7978845608028654f * (y + 0.044715f * y * y * y); const float t = 1.0f - 2.0f / (1.0f + __expf(2.0f * z)); return 0.5f * y * (1.0f + t); }
__device__ __forceinline__ float wave_sum(float v) {
#pragma unroll
    for (int o = 1; o < 64; o <<= 1) v += __shfl_xor(v, o);
    return v;
}
#define LDS_WAIT() asm volatile("s_waitcnt lgkmcnt(0)" ::: "memory")

struct EpiSwiglu {
    static constexpr bool PERM = true;
    bf16_t* O; int ldc;
    __device__ __forceinline__ void operator()(const f32x4 (&acc)[2][2][4][2], const pg8::Unit& u, int wr, int wc, int fr, int fq) const {
        const int row0 = u.pm * 256 + wr * 64 + fr, col0 = u.pn * 128 + wc * 32 + 8 * fq;
#pragma unroll
        for (int ai = 0; ai < 2; ++ai)
#pragma unroll
            for (int m = 0; m < 4; ++m) {
                const f32x4 g0 = acc[ai][0][m][0], g1 = acc[ai][0][m][1], u0 = acc[ai][1][m][0], u1 = acc[ai][1][m][1];
                u32x4 w;
                w.x = cvt_pk_bf16(siluf_(g0[0]) * u0[0], siluf_(g0[1]) * u0[1]); w.y = cvt_pk_bf16(siluf_(g0[2]) * u0[2], siluf_(g0[3]) * u0[3]);
                w.z = cvt_pk_bf16(siluf_(g1[0]) * u1[0], siluf_(g1[1]) * u1[1]); w.w = cvt_pk_bf16(siluf_(g1[2]) * u1[2], siluf_(g1[3]) * u1[3]);
                *(u32x4*)(O + (size_t)(row0 + ai * 128 + m * 16) * ldc + col0) = w;
                asm volatile("" ::: "memory");
            }
    }
};
struct EpiYraw {
    static constexpr bool PERM = true;
    bf16_t* O; float* part;
    __device__ __forceinline__ void operator()(const f32x4 (&acc)[2][2][4][2], const pg8::Unit& u, int wr, int wc, int fr, int fq) const {
        const int row0 = u.pm * 256 + wr * 64 + fr, col0 = u.pn * 256 + wc * 32 + 8 * fq;
#pragma unroll
        for (int ai = 0; ai < 2; ++ai)
#pragma unroll
            for (int m = 0; m < 4; ++m) {
                const int row = row0 + ai * 128 + m * 16; float ss = 0.f;
#pragma unroll
                for (int bj = 0; bj < 2; ++bj) { const f32x4 v0 = acc[ai][bj][m][0], v1 = acc[ai][bj][m][1];
                    ss += (v0[0] * v0[0] + v0[1] * v0[1]) + (v0[2] * v0[2] + v0[3] * v0[3]) + (v1[0] * v1[0] + v1[1] * v1[1]) + (v1[2] * v1[2] + v1[3] * v1[3]);
                    u32x4 w; w.x = cvt_pk_bf16(v0[0], v0[1]); w.y = cvt_pk_bf16(v0[2], v0[3]); w.z = cvt_pk_bf16(v1[0], v1[1]); w.w = cvt_pk_bf16(v1[2], v1[3]);
                    *(u32x4*)(O + (size_t)row * DM + col0 + bj * 128) = w; }
                ss += __shfl_xor(ss, 16); ss += __shfl_xor(ss, 32);
                if (fq == 0) part[(size_t)row * 16 + u.pn * 4 + wc] = ss;
                asm volatile("" ::: "memory");
            }
    }
};
struct EpiInproj {
    static constexpr bool PERM = true;
    bf16_t *QKV, *Z, *U; float *BETA, *G; const float *a_log, *dt_bias;
    __device__ __forceinline__ void operator()(const f32x4 (&acc)[2][2][4][2], const pg8::Unit& u, int wr, int wc, int fr, int fq) const {
        const int row0 = u.pm * 256 + wr * 64 + fr;
        if (u.pn == 10) {
            if (wc == 0 && fq == 0) {
                const f32x4 al = *(const f32x4*)a_log, db = *(const f32x4*)dt_bias;
#pragma unroll
                for (int ai = 0; ai < 2; ++ai)
#pragma unroll
                    for (int m = 0; m < 4; ++m) { const int row = row0 + ai * 128 + m * 16; const f32x4 bi = acc[ai][0][m][0], an = acc[ai][0][m][1]; f32x4 bo, go;
#pragma unroll
                        for (int j = 0; j < 4; ++j) { bo[j] = 1.0f / (1.0f + expf(-bi[j])); const float xx = an[j] + db[j]; const float sp = xx > 20.f ? xx : log1pf(expf(xx)); go[j] = -expf(al[j]) * sp; }
                        *(f32x4*)(BETA + (size_t)row * 4) = bo; *(f32x4*)(G + (size_t)row * 4) = go; asm volatile("" ::: "memory"); }
            }
            return;
        }
        bf16_t* base; int ldc, colt;
        if (u.pn < 6) { base = QKV; ldc = 1536; colt = u.pn * 256; } else if (u.pn < 8) { base = Z; ldc = 512; colt = (u.pn - 6) * 256; } else { base = U; ldc = 512; colt = (u.pn - 8) * 256; }
        const int col0 = colt + wc * 32 + 8 * fq;
#pragma unroll
        for (int ai = 0; ai < 2; ++ai)
#pragma unroll
            for (int m = 0; m < 4; ++m)
#pragma unroll
                for (int bj = 0; bj < 2; ++bj) { const f32x4 v0 = acc[ai][bj][m][0], v1 = acc[ai][bj][m][1];
                    u32x4 w; w.x = cvt_pk_bf16(v0[0], v0[1]); w.y = cvt_pk_bf16(v0[2], v0[3]); w.z = cvt_pk_bf16(v1[0], v1[1]); w.w = cvt_pk_bf16(v1[2], v1[3]);
                    *(u32x4*)(base + (size_t)(row0 + ai * 128 + m * 16) * ldc + col0 + bj * 128) = w; asm volatile("" ::: "memory"); }
    }
};
struct EpiGlu {
    static constexpr bool PERM = true;
    const bf16_t* YS; bf16_t* YCAT;
    __device__ __forceinline__ void operator()(const f32x4 (&acc)[2][2][4][2], const pg8::Unit& u, int wr, int wc, int fr, int fq) const {
        const int row0 = u.pm * 256 + wr * 64 + fr, col0 = u.pn * 256 + wc * 32 + 8 * fq;
#pragma unroll
        for (int ai = 0; ai < 2; ++ai)
#pragma unroll
            for (int m = 0; m < 4; ++m)
#pragma unroll
                for (int bj = 0; bj < 2; ++bj) { const int row = row0 + ai * 128 + m * 16, col = col0 + bj * 128;
                    const u32x4 y = *(const u32x4*)(YS + (size_t)row * 512 + col); const f32x4 v0 = acc[ai][bj][m][0], v1 = acc[ai][bj][m][1];
                    u32x4 w; w.x = cvt_pk_bf16(bflo(y.x) * sigmoidf_(v0[0]), bfhi(y.x) * sigmoidf_(v0[1])); w.y = cvt_pk_bf16(bflo(y.y) * sigmoidf_(v0[2]), bfhi(y.y) * sigmoidf_(v0[3]));
                    w.z = cvt_pk_bf16(bflo(y.z) * sigmoidf_(v1[0]), bfhi(y.z) * sigmoidf_(v1[1])); w.w = cvt_pk_bf16(bflo(y.w) * sigmoidf_(v1[2]), bfhi(y.w) * sigmoidf_(v1[3]));
                    *(u32x4*)(YCAT + (size_t)row * DM + 512 + col) = w; asm volatile("" ::: "memory"); }
    }
};

constexpr size_t MiB = 1u << 20;
constexpr size_t W_FF_IN = (size_t)2 * DFF * DM * 2, W_FF_OUT = (size_t)DM * DFF * 2, W_MIX_IN = (size_t)MIXN * DM * 2, W_GLU = 512 * 512 * 2, W_MIX_OUT = (size_t)DM * DM * 2;
constexpr size_t WO_FF1_IN = 0, WO_FF1_OUT = WO_FF1_IN + W_FF_IN, WO_MIX_IN = WO_FF1_OUT + W_FF_OUT, WO_GLU = WO_MIX_IN + W_MIX_IN, WO_MIX_OUT = WO_GLU + W_GLU,
                 WO_FF2_IN = WO_MIX_OUT + W_MIX_OUT, WO_FF2_OUT = WO_FF2_IN + W_FF_IN, W_LAYER = WO_FF2_OUT + W_FF_OUT;
static_assert(W_LAYER * 2 <= 84 * MiB, "weights");
constexpr size_t WS_W = 0, WS_H = 84 * MiB, WS_BIG = 148 * MiB, WS_YR = 324 * MiB, WS_EX = 388 * MiB, WS_SMALL = 500 * MiB, WS_END = 512 * MiB;
constexpr size_t WS_QKV = WS_BIG, WS_Z = WS_BIG + 96 * MiB, WS_U = WS_BIG + 128 * MiB;
constexpr size_t WS_SC = WS_BIG;
constexpr size_t WS_D = WS_EX, WS_RT = WS_YR;
constexpr size_t WS_QP = WS_H, WS_O0T = WS_H + 32 * MiB;
constexpr size_t WS_YS = WS_EX + 64 * MiB;
constexpr size_t WS_YCAT = WS_EX;
constexpr size_t WS_PART = WS_SMALL, WS_MOD = WS_PART + 2 * MiB, WS_BETA = WS_MOD + 1 * MiB, WS_G = WS_BETA + 1 * MiB, WS_EGL = WS_G + 1 * MiB, WS_S5E = WS_EGL + 1 * MiB;
static_assert(WS_S5E + 2 * MiB <= WS_END, "small");
constexpr int LDS_BYTES = 147456;
#ifndef REP_A
#define REP_A 1
#endif
#ifndef REP_B
#define REP_B 1
#endif
#ifndef REP_C
#define REP_C 1
#endif
constexpr size_t WS_CTL = WS_SMALL + 10 * MiB, CTL_BYTES = 16384;

struct Args { const float* in[29]; float* out; unsigned char* ws; int rep_a, rep_b, rep_c, pad; };

__device__ __forceinline__ int src_col(int maptype, int n) {
    if (maptype == 0) return n;
    if (maptype == 1) { const int t = n >> 8, w = n & 255; return (w < 128) ? t * 128 + w : DFF + t * 128 + (w - 128); }
    return n < 2048 ? n : (n < 2560 ? n + 8 : (n < 2568 ? n - 512 : -1));
}
__device__ __forceinline__ void transpose_item(const float* W, int K, int N, bf16_t* WT, LAS float* scr, int kb, int nb, int maptype, int lane) {
    const int k0 = 64 * kb, n0 = 32 * nb; const int sc = src_col(maptype, n0 + (lane & 31));
#pragma unroll 8
    for (int i = 0; i < 32; ++i) { const int kk = 2 * i + (lane >> 5); scr[kk * 33 + (lane & 31)] = sc >= 0 ? W[(size_t)(k0 + kk) * N + sc] : 0.f; }
    LDS_WAIT(); asm volatile("" ::: "memory");
    const int c = lane & 7;
#pragma unroll
    for (int j = 0; j < 4; ++j) { const int n = (lane >> 3) + 8 * j; const LAS float* s = scr + (8 * c) * 33 + n;
        u32x4 o; o.x = cvt_pk_bf16(s[0 * 33], s[1 * 33]); o.y = cvt_pk_bf16(s[2 * 33], s[3 * 33]); o.z = cvt_pk_bf16(s[4 * 33], s[5 * 33]); o.w = cvt_pk_bf16(s[6 * 33], s[7 * 33]);
        *(u32x4*)(WT + (size_t)(n0 + n) * K + k0 + 8 * c) = o; }
    LDS_WAIT(); asm volatile("" ::: "memory");
}

__device__ __forceinline__ void finalize_phase(const float* xsrc, float* xdst, const bf16_t* yraw, const float* part, const float* gate  , float gs, const float* wpost,
                                               const float* wpre, const float* shift, const float* scale, bf16_t* H, int gw, int NGW, int lane) {
    asm volatile("" : "+v"(lane));
    for (int m = gw; m < M; m += NGW) {
        const int b = m / SEQ;
        f32x4 x[4];
#pragma unroll
        for (int j = 0; j < 4; ++j) x[j] = *(const f32x4*)(xsrc + (size_t)m * DM + 4 * lane + 256 * j);
        if (yraw) {
            float ss = 0.f;
#pragma unroll
            for (int q = 0; q < 4; ++q) { const f32x4 p = *(const f32x4*)(part + (size_t)m * 16 + 4 * q); ss += (p[0] + p[1]) + (p[2] + p[3]); }
            const float rstd = rsqrtf(ss * (1.0f / DM) + EPS) * gs;
#pragma unroll
            for (int j = 0; j < 4; ++j) { const int col = 4 * lane + 256 * j; const u32x2 y = *(const u32x2*)(yraw + (size_t)m * DM + col);
                const f32x4 gt = *(const f32x4*)(gate + (size_t)b * NMOD + col), wp = *(const f32x4*)(wpost + col);
                x[j][0] += gt[0] * wp[0] * rstd * bflo(y.x); x[j][1] += gt[1] * wp[1] * rstd * bfhi(y.x); x[j][2] += gt[2] * wp[2] * rstd * bflo(y.y); x[j][3] += gt[3] * wp[3] * rstd * bfhi(y.y);
                *(f32x4*)(xdst + (size_t)m * DM + col) = x[j]; }
        }
        if (H) {
            float s2 = 0.f;
#pragma unroll
            for (int j = 0; j < 4; ++j) s2 += (x[j][0] * x[j][0] + x[j][1] * x[j][1]) + (x[j][2] * x[j][2] + x[j][3] * x[j][3]);
            const float r2 = rsqrtf(wave_sum(s2) * (1.0f / DM) + EPS);
#pragma unroll
            for (int j = 0; j < 4; ++j) { const int col = 4 * lane + 256 * j; const f32x4 wp = *(const f32x4*)(wpre + col), sh = *(const f32x4*)(shift + (size_t)b * NMOD + col), sc = *(const f32x4*)(scale + (size_t)b * NMOD + col);
                u32x2 o; o.x = cvt_pk_bf16(x[j][0] * r2 * wp[0] * (1.f + sc[0]) + sh[0], x[j][1] * r2 * wp[1] * (1.f + sc[1]) + sh[1]);
                o.y = cvt_pk_bf16(x[j][2] * r2 * wp[2] * (1.f + sc[2]) + sh[2], x[j][3] * r2 * wp[3] * (1.f + sc[3]) + sh[3]);
                *(u32x2*)(H + (size_t)m * DM + col) = o; }
        }
    }
}

__device__ __forceinline__ f32x4 mma_nt(lp_t A, int lda_b, lp_t B, int ldb_b, int nkt, int fr, int fq, f32x4 acc) {
    for (int kt = 0; kt < nkt; ++kt) {
        const bf16x8 a = *(const LAS bf16x8*)(A + fr * lda_b + (kt * 32 + fq * 8) * 2);
        const bf16x8 b = *(const LAS bf16x8*)(B + fr * ldb_b + (kt * 32 + fq * 8) * 2);
        acc = __builtin_amdgcn_mfma_f32_16x16x32_bf16(a, b, acc, 0, 0, 0);
    }
    return acc;
}

constexpr int GP_KN = 0, GP_QS = 17408, GP_V = 34816, GP_KST = 51200, GP_ATT = 67584, GP_A = 76800, GP_TT = 93184, GP_GC = 130048, GP_BETA = 130304, GP_BG = 130560, GP_END = 130816;
constexpr int LD136 = 272, LD72 = 144, LDV = 256, LDKS = 128;
__device__ __forceinline__ void gdn_pre_unit(lp_t lds, int u, const bf16_t* QKV, const float* convw, const float* BETA, const float* G,
                                             bf16_t* Dg, bf16_t* RTg, bf16_t* QPg, bf16_t* O0Tg, float* EGL) {
    int tid_ = threadIdx.x; asm volatile("" : "+v"(tid_));
    const int tid = tid_, wid = __builtin_amdgcn_readfirstlane(tid >> 6), lane = tid & 63, fr = lane & 15, fq = lane >> 4;
    const int b = u >> 9, h = (u >> 7) & 3, c = u & 127;
    const size_t row0 = (size_t)b * SEQ + (size_t)c * CH;
    LAS float* sGC = (LAS float*)(lds + GP_GC); LAS float* sBE = (LAS float*)(lds + GP_BETA);
    if (wid == 0) {
        float v = G[(row0 + lane) * 4 + h];
#ifdef DBG_CONST_GB
        v = -0.01f;
#endif
#pragma unroll
        for (int o = 1; o < 64; o <<= 1) { const float t = __shfl_up(v, o); if (lane >= o) v += t; }
        float be = BETA[(row0 + lane) * 4 + h];
#ifdef DBG_CONST_GB
        be = 0.5f;
#endif
        sGC[lane] = v; sBE[lane] = be; *(LAS float*)(lds + GP_BG + lane * 4) = be * expf(v);
    }
    __syncthreads();
    const float gl = sGC[63];
    {
        const int i = tid >> 3, d0 = (tid & 7) * 16; const float gci = sGC[i];
        u32x4 xq[3][4][2];
#pragma unroll
        for (int part = 0; part < 3; ++part)
#pragma unroll
            for (int j = 0; j < 4; ++j) {
                const int t = c * CH + i - 3 + j; const int tc = t >= 0 ? t : 0;
                const bf16_t* src = QKV + ((size_t)b * SEQ + tc) * 1536 + part * 512 + h * 128 + d0;
                u32x4 x0 = *(const u32x4*)src, x1 = *(const u32x4*)(src + 8);
                if (t < 0) { x0 = (u32x4){0u, 0u, 0u, 0u}; x1 = x0; }
                xq[part][j][0] = x0; xq[part][j][1] = x1;
            }
#pragma unroll
        for (int part = 0; part < 3; ++part) {
            const int ch0 = part * 512 + h * 128 + d0;
            float a[16];
#pragma unroll
            for (int e = 0; e < 16; ++e) a[e] = 0.f;
#pragma unroll
            for (int j = 0; j < 4; ++j) {
                const float* wj = convw + j * 1536 + ch0; const u32x4 x0 = xq[part][j][0], x1 = xq[part][j][1];
                const f32x4 w0 = *(const f32x4*)wj, w1 = *(const f32x4*)(wj + 4), w2 = *(const f32x4*)(wj + 8), w3 = *(const f32x4*)(wj + 12);
                a[0] += w0[0] * bflo(x0.x); a[1] += w0[1] * bfhi(x0.x); a[2] += w0[2] * bflo(x0.y); a[3] += w0[3] * bfhi(x0.y);
                a[4] += w1[0] * bflo(x0.z); a[5] += w1[1] * bfhi(x0.z); a[6] += w1[2] * bflo(x0.w); a[7] += w1[3] * bfhi(x0.w);
                a[8] += w2[0] * bflo(x1.x); a[9] += w2[1] * bfhi(x1.x); a[10] += w2[2] * bflo(x1.y); a[11] += w2[3] * bfhi(x1.y);
                a[12] += w3[0] * bflo(x1.z); a[13] += w3[1] * bfhi(x1.z); a[14] += w3[2] * bflo(x1.w); a[15] += w3[3] * bfhi(x1.w);
            }
            float ss = 0.f;
#pragma unroll
            for (int e = 0; e < 16; ++e) { a[e] = a[e] / (1.0f + __expf(-a[e])); ss += a[e] * a[e]; }
            ss += __shfl_xor(ss, 1); ss += __shfl_xor(ss, 2); ss += __shfl_xor(ss, 4);
            float sc = 1.f;
            if (part == 0) sc = rsqrtf(ss + EPS) * 0.08838834764831845f; else if (part == 1) sc = rsqrtf(ss + EPS);
            const lp_t dst = lds + (part == 0 ? GP_QS : (part == 1 ? GP_KN : GP_V)) + i * (part == 2 ? LDV : LD136) + d0 * 2;
            u32x4 o0, o1;
            o0.x = cvt_pk_bf16(a[0] * sc, a[1] * sc); o0.y = cvt_pk_bf16(a[2] * sc, a[3] * sc); o0.z = cvt_pk_bf16(a[4] * sc, a[5] * sc); o0.w = cvt_pk_bf16(a[6] * sc, a[7] * sc);
            o1.x = cvt_pk_bf16(a[8] * sc, a[9] * sc); o1.y = cvt_pk_bf16(a[10] * sc, a[11] * sc); o1.z = cvt_pk_bf16(a[12] * sc, a[13] * sc); o1.w = cvt_pk_bf16(a[14] * sc, a[15] * sc);
            *(LAS u32x4*)dst = o0; *(LAS u32x4*)(dst + 16) = o1;
            if (part == 1) { const float ks = sc * expf(gl - gci);
#pragma unroll
                for (int e = 0; e < 16; ++e) *(LAS unsigned short*)(lds + GP_KST + (d0 + e) * LDKS + i * 2) = f2bf(a[e] * ks); }
        }
    }
    __syncthreads();
    {
#pragma unroll 1
        for (int q = 0; q < 4; ++q) {
            const int idx = wid * 4 + q, isq = idx >> 4, mt = (idx >> 2) & 3, nt = idx & 3;
            f32x4 acc = (f32x4){0.f, 0.f, 0.f, 0.f};
            acc = mma_nt(lds + (isq ? GP_QS : GP_KN) + mt * 16 * LD136, LD136, lds + GP_KN + nt * 16 * LD136, LD136, 4, fr, fq, acc);
            const int jc = nt * 16 + fr; const float gcj = sGC[jc];
#pragma unroll
            for (int jj = 0; jj < 4; ++jj) { const int i = mt * 16 + 4 * fq + jj; const float dec = expf(fminf(sGC[i] - gcj, 0.f));
                if (isq) *(LAS unsigned short*)(lds + GP_ATT + i * LD72 + jc * 2) = f2bf(i >= jc ? acc[jj] * dec : 0.f);
                else *(LAS float*)(lds + GP_A + (i * 64 + jc) * 4) = (i > jc) ? sBE[i] * acc[jj] * dec : 0.f; }
        }
    }
    __syncthreads();
    if (wid < 4) {
        const int col = wid * 64 + lane;
        unsigned lbA = (unsigned)(size_t)(lds + GP_A), lbS = (unsigned)(size_t)(lds + (wid < 2 ? GP_BETA : GP_BG));
        asm volatile("" : "+v"(lbA), "+v"(lbS));
        const lp_t pA = (lp_t)lbA, pS = (lp_t)lbS;
        const lp_t pR = (wid < 2) ? (lds + GP_V + col * 2) : (lds + GP_KN + (col - 128) * 2);
        float T[64];
#pragma unroll
        for (int i = 0; i < 64; ++i) {
            float acc = *(const LAS float*)(pS + i * 4) * bf2f(*(const LAS unsigned short*)(pR + i * (wid < 2 ? LDV : LD136)));
#pragma unroll
#ifdef DBG_NOSOLVE
            for (int j4 = 0; j4 < 0; ++j4) { const f32x4 a = *(const LAS f32x4*)(pA + (i * 64 + j4 * 4) * 4);
#else
            for (int j4 = 0; j4 < (i + 3) / 4; ++j4) { const f32x4 a = *(const LAS f32x4*)(pA + (i * 64 + j4 * 4) * 4);
#endif
                acc = __builtin_fmaf(-a[0], T[j4 * 4], acc);
                if (j4 * 4 + 1 < i) acc = __builtin_fmaf(-a[1], T[j4 * 4 + 1], acc);
                if (j4 * 4 + 2 < i) acc = __builtin_fmaf(-a[2], T[j4 * 4 + 2], acc);
                if (j4 * 4 + 3 < i) acc = __builtin_fmaf(-a[3], T[j4 * 4 + 3], acc); }
            T[i] = acc;
            asm volatile("" ::: "memory");
        }
        const lp_t pT = lds + GP_TT + col * LD72;
#pragma unroll
        for (int q = 0; q < 8; ++q) { u32x4 o; o.x = cvt_pk_bf16(T[8 * q], T[8 * q + 1]); o.y = cvt_pk_bf16(T[8 * q + 2], T[8 * q + 3]); o.z = cvt_pk_bf16(T[8 * q + 4], T[8 * q + 5]); o.w = cvt_pk_bf16(T[8 * q + 6], T[8 * q + 7]);
            *(LAS u32x4*)(pT + q * 16) = o; }
    }
    __syncthreads();
    {
        bf16_t* Du = Dg + (size_t)u * 16384; bf16_t* RTu = RTg + (size_t)u * 16384; bf16_t* QPu = QPg + (size_t)u * 8192; bf16_t* O0u = O0Tg + (size_t)u * 8192;
#pragma unroll 1
        for (int q = 0; q < 24; ++q) {
            const int idx = wid * 24 + q;
            f32x4 acc = (f32x4){0.f, 0.f, 0.f, 0.f};
            if (idx < 32) {
                const int dt = idx >> 2, it = idx & 3;
                acc = mma_nt(lds + GP_TT + (128 + dt * 16) * LD72, LD72, lds + GP_ATT + it * 16 * LD72, LD72, 2, fr, fq, acc);
                const int i = it * 16 + fr, d = dt * 16 + 4 * fq; const float eg = expf(sGC[i]);
                const u32x2 qv = *(const LAS u32x2*)(lds + GP_QS + i * LD136 + d * 2);
                u32x2 o; o.x = cvt_pk_bf16(bflo(qv.x) * eg - acc[0], bfhi(qv.x) * eg - acc[1]); o.y = cvt_pk_bf16(bflo(qv.y) * eg - acc[2], bfhi(qv.y) * eg - acc[3]);
                *(u32x2*)(QPu + i * 128 + d) = o;
            } else if (idx < 64) {
                const int it = (idx - 32) >> 3, nt = (idx - 32) & 7;
                acc = mma_nt(lds + GP_ATT + it * 16 * LD72, LD72, lds + GP_TT + nt * 16 * LD72, LD72, 2, fr, fq, acc);
                const int n = nt * 16 + fr, i = it * 16 + 4 * fq;
#ifdef DBG_O0PATTERN
                acc[0] = 0.01f * (float)((n + i) & 31); acc[1] = -acc[0]; acc[2] = 0.5f * acc[0]; acc[3] = 0.25f;
#endif
                u32x2 o; o.x = cvt_pk_bf16(acc[0], acc[1]); o.y = cvt_pk_bf16(acc[2], acc[3]);
                *(u32x2*)(O0u + n * 64 + i) = o;
            } else if (idx < 128) {
                const int kt = (idx - 64) >> 3, mt = (idx - 64) & 7;
                acc = mma_nt(lds + GP_TT + (128 + kt * 16) * LD72, LD72, lds + GP_KST + mt * 16 * LDKS, LDKS, 2, fr, fq, acc);
                const int m = mt * 16 + fr, k = kt * 16 + 4 * fq;
                u32x2 o; o.x = cvt_pk_bf16(acc[0], acc[1]); o.y = cvt_pk_bf16(acc[2], acc[3]);
                *(u32x2*)(Du + m * 128 + k) = o;
            } else {
                const int mt = (idx - 128) >> 3, nt = (idx - 128) & 7;
                acc = mma_nt(lds + GP_KST + mt * 16 * LDKS, LDKS, lds + GP_TT + nt * 16 * LD72, LD72, 2, fr, fq, acc);
                const int n = nt * 16 + fr, m = mt * 16 + 4 * fq;
                u32x2 o; o.x = cvt_pk_bf16(acc[0], acc[1]); o.y = cvt_pk_bf16(acc[2], acc[3]);
                *(u32x2*)(RTu + n * 128 + m) = o;
            }
        }
        if (tid == 0) EGL[u] = expf(gl);
    }
    __syncthreads();
}

constexpr int SCAN_WGS = 64, SCAN_IMG = 32 * 272;
struct ScanSet { bf16x8 d[2][4]; u32x2 r[2]; float egl; };
__device__ __forceinline__ void scan_load(ScanSet& R, const bf16_t* Dg, const bf16_t* RTg, const float* EGL, int u, unsigned offD, unsigned offR) {
    const bf16_t* Du = Dg + (size_t)u * 16384; const bf16_t* RTu = RTg + (size_t)u * 16384;
#pragma unroll
    for (int mt = 0; mt < 2; ++mt) {
#pragma unroll
        for (int kt = 0; kt < 4; ++kt) R.d[mt][kt] = *(const bf16x8*)(Du + offD + mt * 16 * 128 + kt * 32);
        R.r[mt] = *(const u32x2*)(RTu + offR + mt * 16);
    }
    R.egl = EGL[u];
}
__device__ __forceinline__ void scan_step(lp_t lds, int cur, const ScanSet& R, f32x4 (&acc)[2], bf16_t* SCg, int u, int cq, int rq, unsigned offS, int fr, int fq) {
    const lp_t img = lds + cur * SCAN_IMG + (16 * cq + fr) * LD136 + fq * 16, nimg = lds + (cur ^ 1) * SCAN_IMG + (16 * cq + fr) * LD136 + (32 * rq + 4 * fq) * 2;
    bf16_t* SCu = SCg + (size_t)u * 16384 + offS;
    bf16x8 b[4];
#pragma unroll
    for (int kt = 0; kt < 4; ++kt) b[kt] = *(const LAS bf16x8*)(img + kt * 64);
    *(bf16x8*)SCu = (rq == 0) ? b[0] : ((rq == 1) ? b[1] : ((rq == 2) ? b[2] : b[3]));
#pragma unroll
    for (int mt = 0; mt < 2; ++mt) {
        f32x4 t = (f32x4){0.f, 0.f, 0.f, 0.f};
#pragma unroll
        for (int kt = 0; kt < 4; ++kt) t = __builtin_amdgcn_mfma_f32_16x16x32_bf16(R.d[mt][kt], b[kt], t, 0, 0, 0);
        f32x4& a = acc[mt]; const u32x2 r = R.r[mt];
        a[0] = R.egl * a[0] + bflo(r.x) - t[0]; a[1] = R.egl * a[1] + bfhi(r.x) - t[1];
        a[2] = R.egl * a[2] + bflo(r.y) - t[2]; a[3] = R.egl * a[3] + bfhi(r.y) - t[3];
        u32x2 o; o.x = cvt_pk_bf16(a[0], a[1]); o.y = cvt_pk_bf16(a[2], a[3]);
        *(LAS u32x2*)(nimg + mt * 32) = o;
    }
}
__device__ __forceinline__ void gdn_scan(lp_t lds, int sx, const bf16_t* Dg, const bf16_t* RTg, const float* EGL, bf16_t* SCg) {
    int tid_ = threadIdx.x; asm volatile("" : "+v"(tid_));
    const int tid = tid_, wid = __builtin_amdgcn_readfirstlane(tid >> 6), lane = tid & 63, fr = lane & 15, fq = lane >> 4;
    const int kx = sx >> 3, bh = (sx & 7) + 8 * (kx >> 2), q = kx & 3, cq = wid & 1, rq = wid >> 1, nb = q * 32 + 16 * cq, u0 = bh * NCH;
    unsigned offD = (unsigned)((32 * rq + fr) * 128 + 8 * fq), offR = (unsigned)((nb + fr) * 128 + 32 * rq + 4 * fq), offS = (unsigned)((nb + fr) * 128 + 32 * rq + 8 * fq);
    asm volatile("" : "+v"(offD), "+v"(offR), "+v"(offS));
    for (int i = tid; i < 2 * SCAN_IMG / 4; i += 512) ((LAS unsigned*)lds)[i] = 0u;
    f32x4 acc[2];
    acc[0] = (f32x4){0.f, 0.f, 0.f, 0.f}; acc[1] = (f32x4){0.f, 0.f, 0.f, 0.f};
    ScanSet R0, R1, R2, R3;
    scan_load(R0, Dg, RTg, EGL, u0, offD, offR); scan_load(R1, Dg, RTg, EGL, u0 + 1, offD, offR); scan_load(R2, Dg, RTg, EGL, u0 + 2, offD, offR);
    __syncthreads();
#define SCAN_CL(x) ((x) < NCH ? (x) : NCH - 1)
#pragma unroll 1
    for (int c = 0; c < NCH; c += 4) {
        scan_load(R3, Dg, RTg, EGL, u0 + SCAN_CL(c + 3), offD, offR); scan_step(lds, 0, R0, acc, SCg, u0 + c, cq, rq, offS, fr, fq); __syncthreads();
        scan_load(R0, Dg, RTg, EGL, u0 + SCAN_CL(c + 4), offD, offR); scan_step(lds, 1, R1, acc, SCg, u0 + c + 1, cq, rq, offS, fr, fq); __syncthreads();
        scan_load(R1, Dg, RTg, EGL, u0 + SCAN_CL(c + 5), offD, offR); scan_step(lds, 0, R2, acc, SCg, u0 + c + 2, cq, rq, offS, fr, fq); __syncthreads();
        scan_load(R2, Dg, RTg, EGL, u0 + SCAN_CL(c + 6), offD, offR); scan_step(lds, 1, R3, acc, SCg, u0 + c + 3, cq, rq, offS, fr, fq); __syncthreads();
    }
#undef SCAN_CL
}

__device__ __forceinline__ void gdn_out_pair(int pairidx, const bf16_t* QPg, const bf16_t* O0Tg, const bf16_t* SCg, const bf16_t* Z, const float* gnw, bf16_t* YCAT) {
    int tid_ = threadIdx.x; asm volatile("" : "+v"(tid_));
    const int tid = tid_, wid = __builtin_amdgcn_readfirstlane(tid >> 6), lane = tid & 63, fr = lane & 15, fq = lane >> 4;
    const int u = pairidx * 2 + (wid >> 2), mt = wid & 3;
    const int b = u >> 9, h = (u >> 7) & 3, c = u & 127;
    const bf16_t* QPu = QPg + (size_t)u * 8192; const bf16_t* O0u = O0Tg + (size_t)u * 8192; const bf16_t* SCu = SCg + (size_t)u * 16384;
    bf16x8 a[4];
#pragma unroll
    for (int kt = 0; kt < 4; ++kt) a[kt] = *(const bf16x8*)(QPu + (16 * mt + fr) * 128 + 32 * kt + 8 * fq);
    f32x4 acc[8]; float ss[4] = {0.f, 0.f, 0.f, 0.f};
#pragma unroll
    for (int nt = 0; nt < 8; ++nt) {
        const u32x2 o0 = *(const u32x2*)(O0u + (16 * nt + fr) * 64 + 16 * mt + 4 * fq);
        acc[nt] = (f32x4){bflo(o0.x), bfhi(o0.x), bflo(o0.y), bfhi(o0.y)};
#ifndef DBG_NO_STATE
#pragma unroll
        for (int kt = 0; kt < 4; ++kt) { const bf16x8 bb = *(const bf16x8*)(SCu + (16 * nt + fr) * 128 + 32 * kt + 8 * fq); acc[nt] = __builtin_amdgcn_mfma_f32_16x16x32_bf16(a[kt], bb, acc[nt], 0, 0, 0); }
#endif
#pragma unroll
        for (int j = 0; j < 4; ++j) ss[j] += acc[nt][j] * acc[nt][j];
    }
#pragma unroll
    for (int j = 0; j < 4; ++j) { float s = ss[j]; s += __shfl_xor(s, 1); s += __shfl_xor(s, 2); s += __shfl_xor(s, 4); s += __shfl_xor(s, 8); ss[j] = rsqrtf(s * (1.0f / HD) + EPS); }
    const size_t row0 = (size_t)b * SEQ + (size_t)c * CH + 16 * mt + 4 * fq;
#pragma unroll
    for (int nt = 0; nt < 8; ++nt) { const int n = 16 * nt + fr; const float w = gnw[n];
#pragma unroll
        for (int j = 0; j < 4; ++j) { const float z = bf2f(Z[(row0 + j) * 512 + h * 128 + n]); float ov = acc[nt][j] * ss[j] * w * siluf_(z);
#ifdef DBG_GDN_ZERO
            ov = 0.f;
#endif
#ifdef DBG_ZONLY
            ov = siluf_(z) * w;
#endif
#ifdef DBG_O0ONLY
            ov = acc[nt][j];
#endif
#ifdef DBG_SANITIZE
            if (!(fabsf(ov) < 1e30f)) ov = 0.f;
#endif
            YCAT[(row0 + j) * DM + h * 128 + n] = f2bf(ov); } }
}

typedef short bf16x4 __attribute__((ext_vector_type(4)));
struct S5W { float are, aim; bf16x4 bre[4], bim[4]; };
__device__ __forceinline__ void s5_abar(int g, int p, const float* a_re, const float* a_im, const float* log_dt, float& are, float& aim, float& f_r, float& f_i) {
    const float ar = fminf(a_re[g * 64 + p], -1e-4f), ai = a_im[g * 64 + p], dt = expf(log_dt[g]);
    const float mag = expf(dt * ar); are = mag * cosf(dt * ai); aim = mag * sinf(dt * ai);
    const float den = ar * ar + ai * ai, zr = are - 1.0f, zi = aim; f_r = (zr * ar + zi * ai) / den; f_i = (zi * ar - zr * ai) / den;
}
__device__ __forceinline__ void s5_setup(S5W& W, int g, int lane, const float* a_re, const float* a_im, const float* log_dt, const float* b_re, const float* b_im) {
    float t0, t1; s5_abar(g, lane, a_re, a_im, log_dt, W.are, W.aim, t0, t1);
    const int fr = lane & 15, fq = lane >> 4;
#pragma unroll
    for (int nt = 0; nt < 4; ++nt) { float a_, b_, f_r, f_i; const int p = 16 * nt + fr; s5_abar(g, p, a_re, a_im, log_dt, a_, b_, f_r, f_i);
        const f32x4 br = *(const f32x4*)(b_re + (size_t)(g * 64 + p) * 16 + 4 * fq), bi = *(const f32x4*)(b_im + (size_t)(g * 64 + p) * 16 + 4 * fq);
        u32x2 w; w.x = cvt_pk_bf16(f_r * br[0] - f_i * bi[0], f_r * br[1] - f_i * bi[1]); w.y = cvt_pk_bf16(f_r * br[2] - f_i * bi[2], f_r * br[3] - f_i * bi[3]); W.bre[nt] = __builtin_bit_cast(bf16x4, w);
        w.x = cvt_pk_bf16(f_r * bi[0] + f_i * br[0], f_r * bi[1] + f_i * br[1]); w.y = cvt_pk_bf16(f_r * bi[2] + f_i * br[2], f_r * bi[3] + f_i * br[3]); W.bim[nt] = __builtin_bit_cast(bf16x4, w); }
}
constexpr int S5_BUT = 0, S5_LDB = 80, S5_XT = 10240, S5_WLDS = 14592;
__device__ __forceinline__ void s5_bu_tile(lp_t wlds, const S5W& W, const u32x2 av, int fr, int fq) {
    const bf16x4 a = __builtin_bit_cast(bf16x4, av);
#pragma unroll
    for (int nt = 0; nt < 4; ++nt) {
        f32x4 c = __builtin_amdgcn_mfma_f32_16x16x16bf16_1k(a, W.bre[nt], (f32x4){0.f, 0.f, 0.f, 0.f}, 0, 0, 0);
        *(LAS f32x4*)(wlds + S5_BUT + (16 * nt + fr) * S5_LDB + fq * 16) = c;
        c = __builtin_amdgcn_mfma_f32_16x16x16bf16_1k(a, W.bim[nt], (f32x4){0.f, 0.f, 0.f, 0.f}, 0, 0, 0);
        *(LAS f32x4*)(wlds + S5_BUT + (64 + 16 * nt + fr) * S5_LDB + fq * 16) = c;
    }
}
__device__ __forceinline__ void s5_pass_a(lp_t wlds, int v, const bf16_t* U, float* E, const float* a_re, const float* a_im, const float* log_dt, const float* b_re, const float* b_im, int lane) {
    asm volatile("" : "+v"(lane));
    const int seg = v & (NSEG - 1), g = (v >> 5) & 31, b = v >> 10, fr = lane & 15, fq = lane >> 4;
    S5W W; s5_setup(W, g, lane, a_re, a_im, log_dt, b_re, b_im);
    float xr = 0.f, xi = 0.f;
    const size_t row0 = (size_t)b * SEQ + (size_t)seg * LSEG;
    u32x2 avn = *(const u32x2*)(U + (row0 + fr) * 512 + g * 16 + 4 * fq);
#pragma unroll 1
    for (int tile = 0; tile < LSEG / 16; ++tile) {
        const u32x2 av = avn; { const size_t rn = row0 + (tile + 1 < LSEG / 16 ? tile + 1 : tile) * 16; avn = *(const u32x2*)(U + (rn + fr) * 512 + g * 16 + 4 * fq); }
        s5_bu_tile(wlds, W, av, fr, fq);
        LDS_WAIT(); asm volatile("" ::: "memory");
        f32x4 re[4], im[4];
#pragma unroll
        for (int q = 0; q < 4; ++q) { re[q] = *(const LAS f32x4*)(wlds + S5_BUT + lane * S5_LDB + q * 16); im[q] = *(const LAS f32x4*)(wlds + S5_BUT + (64 + lane) * S5_LDB + q * 16); }
#pragma unroll
        for (int tt = 0; tt < 16; ++tt) { const float nr = W.are * xr - W.aim * xi + re[tt >> 2][tt & 3], ni = W.are * xi + W.aim * xr + im[tt >> 2][tt & 3]; xr = nr; xi = ni; }
        LDS_WAIT(); asm volatile("" ::: "memory");
    }
    *(f32x2*)(E + ((size_t)v * 64 + lane) * 2) = (f32x2){xr, xi};
}
__device__ __forceinline__ void s5_pass_b(lp_t wlds, int v, const bf16_t* U, const float* E, const float* a_re, const float* a_im, const float* log_dt, const float* b_re, const float* b_im,
                                          const float* c_re, const float* c_im, const float* dvec, bf16_t* YS, int lane) {
    asm volatile("" : "+v"(lane));
    const int seg = v & (NSEG - 1), g = (v >> 5) & 31, b = v >> 10, fr = lane & 15, fq = lane >> 4;
    S5W W; s5_setup(W, g, lane, a_re, a_im, log_dt, b_re, b_im);
    float pr = W.are, pi = W.aim;
#pragma unroll
    for (int s = 0; s < 8; ++s) { const float nr = pr * pr - pi * pi, ni = 2.0f * pr * pi; pr = nr; pi = ni; }
    float xr = 0.f, xi = 0.f;
#pragma unroll 1
    for (int s0 = 0; s0 < seg; s0 += 8) {
        f32x2 e[8];
#pragma unroll
        for (int k = 0; k < 8; ++k) { const int sk = (s0 + k < seg) ? s0 + k : seg - 1; e[k] = *(const f32x2*)(E + ((size_t)(v - seg + sk) * 64 + lane) * 2); }
#pragma unroll
        for (int k = 0; k < 8; ++k) if (s0 + k < seg) { const float nr = pr * xr - pi * xi + e[k][0], ni = pr * xi + pi * xr + e[k][1]; xr = nr; xi = ni; }
    }
    bf16x8 cb[4];
#pragma unroll
    for (int kt = 0; kt < 4; ++kt) { const float* src = (kt < 2 ? c_re : c_im) + (size_t)(g * 16 + fr) * 64 + 32 * (kt & 1) + 8 * fq; const float sg = kt < 2 ? 1.f : -1.f;
        const f32x4 v0 = *(const f32x4*)src, v1 = *(const f32x4*)(src + 4); u32x4 w; w.x = cvt_pk_bf16(sg * v0[0], sg * v0[1]); w.y = cvt_pk_bf16(sg * v0[2], sg * v0[3]); w.z = cvt_pk_bf16(sg * v1[0], sg * v1[1]); w.w = cvt_pk_bf16(sg * v1[2], sg * v1[3]);
        cb[kt] = __builtin_bit_cast(bf16x8, w); }
    const float dco = dvec[g * 16 + fr];
    const lp_t xt = wlds + S5_XT;
    const size_t row0 = (size_t)b * SEQ + (size_t)seg * LSEG;
    u32x2 avn = *(const u32x2*)(U + (row0 + fr) * 512 + g * 16 + 4 * fq); unsigned short uvn[4];
#pragma unroll
    for (int j = 0; j < 4; ++j) uvn[j] = U[(row0 + 4 * fq + j) * 512 + g * 16 + fr];
#pragma unroll 1
    for (int tile = 0; tile < LSEG / 16; ++tile) {
        const size_t r0 = row0 + tile * 16;
        const u32x2 av = avn; float uv[4];
#pragma unroll
        for (int j = 0; j < 4; ++j) uv[j] = bf2f(uvn[j]);
        { const size_t rn = row0 + (tile + 1 < LSEG / 16 ? tile + 1 : tile) * 16; avn = *(const u32x2*)(U + (rn + fr) * 512 + g * 16 + 4 * fq);
#pragma unroll
          for (int j = 0; j < 4; ++j) uvn[j] = U[(rn + 4 * fq + j) * 512 + g * 16 + fr]; }
        s5_bu_tile(wlds, W, av, fr, fq);
        LDS_WAIT(); asm volatile("" ::: "memory");
        f32x4 re[4], im[4];
#pragma unroll
        for (int q = 0; q < 4; ++q) { re[q] = *(const LAS f32x4*)(wlds + S5_BUT + lane * S5_LDB + q * 16); im[q] = *(const LAS f32x4*)(wlds + S5_BUT + (64 + lane) * S5_LDB + q * 16); }
#pragma unroll
        for (int tt = 0; tt < 16; ++tt) { const float nr = W.are * xr - W.aim * xi + re[tt >> 2][tt & 3], ni = W.are * xi + W.aim * xr + im[tt >> 2][tt & 3]; xr = nr; xi = ni;
            *(LAS unsigned short*)(xt + tt * LD136 + lane * 2) = f2bf(xr); *(LAS unsigned short*)(xt + tt * LD136 + (64 + lane) * 2) = f2bf(xi); }
        LDS_WAIT(); asm volatile("" ::: "memory");
        f32x4 acc = (f32x4){0.f, 0.f, 0.f, 0.f};
#pragma unroll
        for (int kt = 0; kt < 4; ++kt) { const bf16x8 a = *(const LAS bf16x8*)(xt + fr * LD136 + (32 * kt + 8 * fq) * 2); acc = __builtin_amdgcn_mfma_f32_16x16x32_bf16(a, cb[kt], acc, 0, 0, 0); }
#pragma unroll
        for (int j = 0; j < 4; ++j) YS[(r0 + 4 * fq + j) * 512 + g * 16 + fr] = f2bf(gelu_tanh(acc[j] + dco * uv[j]));
        LDS_WAIT(); asm volatile("" ::: "memory");
    }
}

#define XB_TMO      128
#define XB_XCNT(j)  (256  + 64 * (j))
#define XB_XSUB(j)  (1280 + 64 * (j))
#define XB_XGEN(j)  (2304 + 64 * (j))
#define XB_TOP      3328
#define XB_TOPGEN   3392
#define XCD_BAR_WORDS 3456
#define XB_SPIN_CAP (1u << 22)
__device__ __forceinline__ unsigned xb_ld(unsigned* p)              { return __hip_atomic_load(p, __ATOMIC_RELAXED, __HIP_MEMORY_SCOPE_AGENT); }
__device__ __forceinline__ unsigned xb_add(unsigned* p, unsigned v) { return __hip_atomic_fetch_add(p, v, __ATOMIC_RELAXED, __HIP_MEMORY_SCOPE_AGENT); }
__device__ __forceinline__ unsigned xb_xcc_id() { return (unsigned)__builtin_amdgcn_s_getreg((3 << 11) | 20) & 0xFu; }
#define XB_SPIN(cond, bar) do { unsigned _sp = 0; while (cond) { __builtin_amdgcn_s_sleep(1); \
    if ((++_sp & 255u) == 0u) { if (xb_ld(&(bar)[XB_TMO])) break; if (_sp > XB_SPIN_CAP) { atomicAdd(&(bar)[XB_TMO], 1u); break; } } } } while (0)
struct XcdBarrier { unsigned* bar; unsigned x; volatile LAS unsigned* st; };
__device__ __forceinline__ XcdBarrier xcd_barrier_post(unsigned* bar, volatile LAS unsigned* st) {
    XcdBarrier b; b.bar = bar; b.x = xb_xcc_id(); b.st = st;
    if (threadIdx.x == 0) (void)xb_add(&bar[XB_XCNT(b.x)], 1u);
    return b;
}
__device__ __forceinline__ void xcd_barrier_complete(unsigned* bar, unsigned x, unsigned& nloc, unsigned& nx) {
    const unsigned G = gridDim.x * gridDim.y * gridDim.z;
    unsigned sum, cnt, mine, sp = 0u;
    for (;;) {
        sum = 0u; cnt = 0u; mine = 0u;
#pragma unroll
        for (unsigned j = 0; j < 16; ++j) { const unsigned c = xb_ld(&bar[XB_XCNT(j)]); sum += c; cnt += (c > 0u) ? 1u : 0u; mine = (j == x) ? c : mine; }
        if (sum == G) break;
        __builtin_amdgcn_s_sleep(1);
        if ((++sp & 255u) == 0u) { if (xb_ld(&bar[XB_TMO])) break; if (sp > XB_SPIN_CAP) { atomicAdd(&bar[XB_TMO], 1u); break; } }
    }
    nloc = mine > 0u ? mine : 1u; nx = cnt > 0u ? cnt : 1u;
}
__device__ __forceinline__ void xcd_barrier(const XcdBarrier& b) {
    asm volatile("s_waitcnt vmcnt(0) lgkmcnt(0)" ::: "memory");
    __syncthreads();
    if (threadIdx.x == 0) {
        unsigned* bar = b.bar;
        __builtin_amdgcn_s_waitcnt(0);
        unsigned nloc = b.st[0], nx = b.st[1];
        if (nloc == 0u) { xcd_barrier_complete(bar, b.x, nloc, nx); b.st[0] = nloc; b.st[1] = nx; }
        const unsigned old = xb_add(&bar[XB_XSUB(b.x)], 1u);
        const unsigned gen = old / nloc;
        if (old + 1u == (gen + 1u) * nloc) {
            __builtin_amdgcn_fence(__ATOMIC_RELEASE, "agent");
            asm volatile("s_waitcnt vmcnt(0)" ::: "memory");
            const unsigned og = xb_add(&bar[XB_TOP], 1u);
            const unsigned tg = og / nx;
            if (og + 1u == (tg + 1u) * nx) xb_add(&bar[XB_TOPGEN], 1u);
            else XB_SPIN(xb_ld(&bar[XB_TOPGEN]) == tg, bar);
            __builtin_amdgcn_fence(__ATOMIC_ACQUIRE, "agent");
            xb_add(&bar[XB_XGEN(b.x)], 1u);
            asm volatile("s_waitcnt vmcnt(0)" ::: "memory");
        } else {
            XB_SPIN(xb_ld(&bar[XB_XGEN(b.x)]) == gen, bar);
            __builtin_amdgcn_fence(__ATOMIC_ACQUIRE, "agent");
            asm volatile("s_waitcnt vmcnt(0)" ::: "memory");
        }
    }
    __syncthreads();
}

__global__ void __launch_bounds__(512, 2) hybrid_fwd(Args args) {
    extern __shared__ __attribute__((aligned(16))) unsigned char lds_raw[];
    cg::grid_group grid = cg::this_grid();
    const lp_t lds = (lp_t)lds_raw;
    const int tid = threadIdx.x, lane = tid & 63, wave = __builtin_amdgcn_readfirstlane(tid >> 6);
    const int G = gridDim.x, bx = blockIdx.x, gw = bx * 8 + wave, NGW = G * 8;
    typedef const __attribute__((address_space(4))) Args* kargp_t;
    const kargp_t kp0 = (kargp_t)__builtin_amdgcn_kernarg_segment_ptr();
#define ARGS() ({ kargp_t p_ = kp0; asm volatile("" : "+s"(p_)); p_; })
    unsigned char* ws = ARGS()->ws;
    float* MOD = (float*)(ws + WS_MOD); float* PART = (float*)(ws + WS_PART);
    bf16_t* H = (bf16_t*)(ws + WS_H); bf16_t* HID = (bf16_t*)(ws + WS_BIG); bf16_t* YR = (bf16_t*)(ws + WS_YR);
    {
        if (tid < 16) ((LAS unsigned*)(lds + LDS_BYTES - 64))[tid] = 0u;
        __syncthreads();
    }
    XcdBarrier xbar = xcd_barrier_post((unsigned*)(ws + WS_CTL), (volatile LAS unsigned*)(lds + LDS_BYTES - 64));
    grid.sync();
#define GSYNC() xcd_barrier(xbar)

    {
        LAS float* scr = (LAS float*)(lds + wave * 8704);
        constexpr int I_FFI = 16 * 176, I_FFO = 44 * 32, I_MXI = 16 * 88, I_GLU = 8 * 16, I_MXO = 16 * 32;
        constexpr int I_LAYER = 2 * I_FFI + 2 * I_FFO + I_MXI + I_GLU + I_MXO;
        for (int it = gw; it < DEPTH * I_LAYER; it += NGW) {
            const int l = it / I_LAYER; int r = it % I_LAYER; bf16_t* wl = (bf16_t*)(ws + WS_W + (size_t)l * W_LAYER);
            if (r < I_FFI) { transpose_item(ARGS()->in[6] + (size_t)l * DM * 2 * DFF, DM, 2 * DFF, (bf16_t*)((char*)wl + WO_FF1_IN), scr, r / 176, r % 176, 1, lane); continue; } r -= I_FFI;
            if (r < I_FFO) { transpose_item(ARGS()->in[7] + (size_t)l * DFF * DM, DFF, DM, (bf16_t*)((char*)wl + WO_FF1_OUT), scr, r / 32, r % 32, 0, lane); continue; } r -= I_FFO;
            if (r < I_MXI) { transpose_item(ARGS()->in[10] + (size_t)l * DM * PROJ_W, DM, PROJ_W, (bf16_t*)((char*)wl + WO_MIX_IN), scr, r / 88, r % 88, 2, lane); continue; } r -= I_MXI;
            if (r < I_GLU) { transpose_item(ARGS()->in[23] + (size_t)l * 512 * 512, 512, 512, (bf16_t*)((char*)wl + WO_GLU), scr, r / 16, r % 16, 0, lane); continue; } r -= I_GLU;
            if (r < I_MXO) { transpose_item(ARGS()->in[24] + (size_t)l * DM * DM, DM, DM, (bf16_t*)((char*)wl + WO_MIX_OUT), scr, r / 32, r % 32, 0, lane); continue; } r -= I_MXO;
            if (r < I_FFI) { transpose_item(ARGS()->in[27] + (size_t)l * DM * 2 * DFF, DM, 2 * DFF, (bf16_t*)((char*)wl + WO_FF2_IN), scr, r / 176, r % 176, 1, lane); continue; } r -= I_FFI;
            transpose_item(ARGS()->in[28] + (size_t)l * DFF * DM, DFF, DM, (bf16_t*)((char*)wl + WO_FF2_OUT), scr, r / 32, r % 32, 0, lane);
        }
        __syncthreads();
        LAS float* ca = (LAS float*)lds; LAS float* red = (LAS float*)(lds + 16384);
        for (int i = tid; i < NB * DM; i += 512) { const float v = ARGS()->in[1][i]; ca[i] = v / (1.0f + expf(-v)); }
        __syncthreads();
        for (int it = bx; it < DEPTH * (NMOD / 64); it += G) {
            const int l = it / (NMOD / 64), cb = it % (NMOD / 64), col = cb * 64 + lane;
            const float* wm = ARGS()->in[2] + (size_t)l * DM * NMOD + col;
            float a0 = 0.f, a1 = 0.f, a2 = 0.f, a3 = 0.f;
#pragma unroll 8
            for (int k = wave * 128; k < wave * 128 + 128; ++k) { const float w = wm[(size_t)k * NMOD]; a0 += ca[k] * w; a1 += ca[DM + k] * w; a2 += ca[2 * DM + k] * w; a3 += ca[3 * DM + k] * w; }
            red[(wave * 4 + 0) * 64 + lane] = a0; red[(wave * 4 + 1) * 64 + lane] = a1; red[(wave * 4 + 2) * 64 + lane] = a2; red[(wave * 4 + 3) * 64 + lane] = a3;
            __syncthreads();
            if (tid < 256) { const int b = tid >> 6; float s = ARGS()->in[3][(size_t)l * NMOD + col];
#pragma unroll
                for (int w = 0; w < 8; ++w) s += red[(w * 4 + b) * 64 + lane];
                MOD[((size_t)l * NB + b) * NMOD + col] = s; }
            __syncthreads();
        }
    }
    GSYNC();
    finalize_phase(ARGS()->in[0], nullptr, nullptr, nullptr, nullptr, 0.f, nullptr, ARGS()->in[4], MOD + 0 * DM, MOD + 1 * DM, H, gw, NGW, lane);
    GSYNC();

#pragma unroll 1
    for (int l = 0; l < DEPTH; ++l) {
        const unsigned char* wl = ws + WS_W + (size_t)l * W_LAYER;
        const float* modl = MOD + (size_t)l * NB * NMOD;
#pragma unroll 1
        for (int sub = 0; sub < 3; ++sub) {
#ifdef SKIP_MIX
            if (sub == 1) continue;
#endif
            if (sub != 1) {
                { pg8::Gemm g{H, (const bf16_t*)(wl + (sub == 0 ? WO_FF1_IN : WO_FF2_IN)), M, 2 * DFF, DM, DM, DM}; pg8::StaticOrder S; S.init(M, 2 * DFF, G, bx);
                  EpiSwiglu E{HID, DFF};
#pragma unroll 1
                  for (int rep = 0; rep < ARGS()->rep_a; ++rep) { pg8::gemm_phase<EpiSwiglu, true>(lds, g, S, E); __syncthreads(); }
 }
                GSYNC();
                { pg8::Gemm g{HID, (const bf16_t*)(wl + (sub == 0 ? WO_FF1_OUT : WO_FF2_OUT)), M, DM, DFF, DFF, DFF}; pg8::StaticOrder S; S.init(M, DM, G, bx);
                  EpiYraw E{YR, PART};
#pragma unroll 1
                  for (int rep = 0; rep < ARGS()->rep_a; ++rep) { pg8::gemm_phase<EpiYraw, true>(lds, g, S, E); __syncthreads(); }
 }
                GSYNC();
            } else {
                bf16_t* QKV = (bf16_t*)(ws + WS_QKV); bf16_t* Zb = (bf16_t*)(ws + WS_Z); bf16_t* Ub = (bf16_t*)(ws + WS_U);
                float* BETA = (float*)(ws + WS_BETA); float* Gg = (float*)(ws + WS_G); float* EGL = (float*)(ws + WS_EGL); float* S5E = (float*)(ws + WS_S5E);
                bf16_t* Dg = (bf16_t*)(ws + WS_D); bf16_t* RTg = (bf16_t*)(ws + WS_RT); bf16_t* QPg = (bf16_t*)(ws + WS_QP); bf16_t* O0Tg = (bf16_t*)(ws + WS_O0T);
                bf16_t* SCg = (bf16_t*)(ws + WS_SC); bf16_t* YS = (bf16_t*)(ws + WS_YS); bf16_t* YCAT = (bf16_t*)(ws + WS_YCAT);
                { pg8::Gemm g{H, (const bf16_t*)(wl + WO_MIX_IN), M, MIXN, DM, DM, DM}; pg8::StaticOrder S; S.init(M, MIXN, G, bx);
                  EpiInproj E{QKV, Zb, Ub, BETA, Gg, ARGS()->in[12] + l * 4, ARGS()->in[13] + l * 4};
#ifndef SKIP_GI1
pg8::gemm_phase<EpiInproj, true>(lds, g, S, E);
#endif
 }
                GSYNC();

#pragma unroll 1
                for (int rep = 0; rep < ARGS()->rep_b; ++rep)
                for (int u = bx; u < NUNIT; u += G) gdn_pre_unit(lds, u, QKV, ARGS()->in[11] + (size_t)l * 4 * 1536, BETA, Gg, Dg, RTg, QPg, O0Tg, EGL);

                __syncthreads();

#ifndef SKIP_S5A
                for (int v = gw; v < NB * S5G * NSEG; v += NGW)
                    s5_pass_a(lds + wave * S5_WLDS, v, Ub, S5E, ARGS()->in[15] + l * 2048, ARGS()->in[16] + l * 2048, ARGS()->in[17] + l * 32, ARGS()->in[18] + (size_t)l * 32768, ARGS()->in[19] + (size_t)l * 32768, lane);
#endif

                GSYNC();

#pragma unroll 1
                for (int rep = 0; rep < ARGS()->rep_c; ++rep) { if (bx < SCAN_WGS) gdn_scan(lds, bx, Dg, RTg, EGL, SCg); __syncthreads(); }
                {


#ifndef SKIP_S5B
                if (bx >= SCAN_WGS) for (int v = (bx - SCAN_WGS) * 8 + wave; v < NB * S5G * NSEG; v += (G - SCAN_WGS) * 8)
                    s5_pass_b(lds + wave * S5_WLDS, v, Ub, S5E, ARGS()->in[15] + l * 2048, ARGS()->in[16] + l * 2048, ARGS()->in[17] + l * 32, ARGS()->in[18] + (size_t)l * 32768, ARGS()->in[19] + (size_t)l * 32768,
                              ARGS()->in[20] + (size_t)l * 32768, ARGS()->in[21] + (size_t)l * 32768, ARGS()->in[22] + l * 512, YS, lane);
#endif
                }

                GSYNC();

#ifndef SKIP_OUT
                for (int p = bx; p < NUNIT / 2; p += G) gdn_out_pair(p, QPg, O0Tg, SCg, Zb, ARGS()->in[14] + l * HD, YCAT);
#endif

                { pg8::Gemm g{YS, (const bf16_t*)(wl + WO_GLU), M, 512, 512, 512, 512}; pg8::StaticOrder S; S.init(M, 512, G, bx);
                  EpiGlu E{YS, YCAT};
#ifndef SKIP_GG1
pg8::gemm_phase<EpiGlu, true>(lds, g, S, E);
#endif
 }
                GSYNC();
                { pg8::Gemm g{YCAT, (const bf16_t*)(wl + WO_MIX_OUT), M, DM, DM, DM, DM}; pg8::StaticOrder S; S.init(M, DM, G, bx);
                  EpiYraw E{YR, PART};
#ifndef SKIP_GY2
pg8::gemm_phase<EpiYraw, true>(lds, g, S, E);
#endif
 }
                GSYNC();
            }
            {
                const float* xsrc = (l == 0 && sub == 0) ? ARGS()->in[0] : ARGS()->out;
                const float* wpost = (sub == 0 ? ARGS()->in[5] : (sub == 1 ? ARGS()->in[9] : ARGS()->in[26])) + l * DM;
                const float* gate = modl + (3 * sub + 2) * DM; const float gs = sub == 1 ? 1.0f : 0.5f;
                const bool last = (l == DEPTH - 1 && sub == 2);
                const int nl = sub == 2 ? l + 1 : l, nsub = sub == 2 ? 0 : sub + 1;
                const float* wpre = last ? nullptr : (nsub == 0 ? ARGS()->in[4] : (nsub == 1 ? ARGS()->in[8] : ARGS()->in[25])) + nl * DM;
                const float* modn = MOD + (size_t)(last ? 0 : nl) * NB * NMOD;
                finalize_phase(xsrc, ARGS()->out, YR, PART, gate, gs, wpost, wpre, modn + (3 * nsub) * DM, modn + (3 * nsub + 1) * DM, last ? nullptr : H, gw, NGW, lane);
            }
            GSYNC();
        }
    }
}

extern "C" void kernel_launch(void* const* d_in, const int* in_sizes, int n_in, void* d_out, int out_size, void* d_ws, size_t ws_size, hipStream_t stream) {
    static int grid = 0;
    if (grid == 0) {
        if (n_in != 29 || ws_size < WS_END) { fprintf(stderr, "kernel_launch: unexpected n_in %d or ws %zu\n", n_in, ws_size); grid = -1; return; }
        int dev = 0, cus = 0, per_cu = 0;
        hipGetDevice(&dev); hipDeviceGetAttribute(&cus, hipDeviceAttributeMultiprocessorCount, dev);
        hipFuncSetAttribute((const void*)hybrid_fwd, hipFuncAttributeMaxDynamicSharedMemorySize, LDS_BYTES);
        hipOccupancyMaxActiveBlocksPerMultiprocessor(&per_cu, (const void*)hybrid_fwd, 512, LDS_BYTES);
        if (per_cu < 1) { fprintf(stderr, "kernel_launch: occupancy query says %d blocks per CU\n", per_cu); per_cu = 1; }
        (void)hipGetLastError();
        grid = cus * 1;
    }
    if (grid < 0) return;
    if (hipMemsetAsync((char*)d_ws + WS_CTL, 0, CTL_BYTES, stream) != hipSuccess) { fprintf(stderr, "memset failed\n"); return; }
    Args a{};
    for (int i = 0; i < 29; ++i) a.in[i] = (const float*)d_in[i];
    a.out = (float*)d_out; a.ws = (unsigned char*)d_ws; a.rep_a = REP_A; a.rep_b = REP_B; a.rep_c = REP_C; a.pad = 0;
    void* kargs[] = {&a};
    hipError_t e = hipLaunchCooperativeKernel((const void*)hybrid_fwd, dim3(grid), dim3(512), kargs, LDS_BYTES, stream);
    if (e != hipSuccess) fprintf(stderr, "cooperative launch failed: %s (grid %d)\n", hipGetErrorString(e), grid);
}
```

```cpp
#include <hip/hip_runtime.h>
#include <hip/hip_cooperative_groups.h>
#include <cstdio>
#include <cstdint>
namespace cg = cooperative_groups;

#define LAS __attribute__((address_space(3)))
typedef unsigned short bf16_t;
typedef short bf16x8 __attribute__((ext_vector_type(8)));
typedef float f32x4 __attribute__((ext_vector_type(4)));
typedef float f32x2 __attribute__((ext_vector_type(2)));
typedef unsigned u32x4 __attribute__((ext_vector_type(4)));
typedef unsigned u32x2 __attribute__((ext_vector_type(2)));
typedef LAS unsigned char* lp_t;

constexpr int DM = 1024, NB = 4, SEQ = 8192, M = NB * SEQ, DEPTH = 2;
constexpr int DFF = 2816, NH = 4, HD = 128, CH = 64, NCH = SEQ / CH;
constexpr int NUNIT = NB * NH * NCH;
constexpr int S5G = 32, S5P = 64, S5H = 16, LSEG = 256, NSEG = SEQ / LSEG;
constexpr int NMOD = 9 * DM;
constexpr int PROJ_W = 2568, MIXN = 2816;
constexpr float EPS = 1e-6f;

namespace pg8 {
constexpr int BM = 256, BK = 64, HALF = 128, HTB = HALF * BK * 2, STAGE_BYTES = 8 * HTB, NXCD = 8, WGM = 8;
__device__ __forceinline__ int lds_byte(int r, int c) { const int st = (r >> 4) * 2 + (c >> 5), rr = r & 15, cc = c & 31, ob = rr * 64 + cc * 2; return st * 1024 + (ob ^ (((ob >> 9) & 1) << 5)); }
__device__ __forceinline__ void stage_rc(int b, int& R, int& C) { const int st = b / 1024, sb = b % 1024, swz = sb ^ (((sb >> 9) & 1) << 5); R = (st >> 1) * 16 + swz / 64; C = (st & 1) * 32 + (swz % 64) / 2; }
__device__ __forceinline__ int perm32(int rho) { const int n = rho >> 4, i = rho & 15; return 8 * (i >> 2) + 4 * n + (i & 3); }
struct Unit { int pm, pn; };
struct Gemm { const bf16_t* A; const bf16_t* Bt; int M, N, K, lda, ldb; };
struct StaticOrder {
    int nM, nN, nwg, G, c;
    __device__ void init(int M_, int N_, int G_, int c_) { nM = M_ / BM; nN = N_ / BM; nwg = nM * nN; G = G_; c = c_; }
    __device__ bool next(int i, Unit& u) const {
        const long L = (long)i * G + c; if (L >= nwg) return false;
        int wgid = (int)L; { const int q = nwg / NXCD, r = nwg % NXCD, xcd = wgid % NXCD, off = wgid / NXCD; wgid = (xcd < r ? xcd * (q + 1) : r * (q + 1) + (xcd - r) * q) + off; }
        const int nig = WGM * nN, gid = wgid / nig, fm = gid * WGM, gsz = (nM - fm) < WGM ? (nM - fm) : WGM;
        u.pm = fm + ((wgid % nig) % gsz); u.pn = (wgid % nig) / gsz; return true;
    }
};
typedef __bf16 bf16x2_t __attribute__((ext_vector_type(2)));
__device__ __forceinline__ unsigned cvt_pk_bf16(float lo, float hi) { f32x2 v = {lo, hi}; bf16x2_t b = __builtin_convertvector(v, bf16x2_t); return __builtin_bit_cast(unsigned, b); }

template <class Epi, bool ALIGN_EPI>
__device__ __forceinline__ void gemm_phase(lp_t lds, const Gemm g, const StaticOrder& S, const Epi& E) {
    int tid_ = threadIdx.x; asm volatile("" : "+v"(tid_));
    const int tid = tid_, wid = __builtin_amdgcn_readfirstlane(tid >> 6), lane = tid & 63, wr = wid >> 2, wc = wid & 3, fr = lane & 15, fq = lane >> 4;
    const int K = g.K, nt = K / BK;
    unsigned voffA[2], voffB[2];
#pragma unroll
    for (int i = 0; i < 2; ++i) { int R, C; stage_rc(tid * 16 + i * 8192, R, C); const int Rb = Epi::PERM ? ((R & ~31) + perm32(R & 31)) : R;
        voffA[i] = (unsigned)(R * g.lda + C) * 2u; voffB[i] = (unsigned)(Rb * g.ldb + C) * 2u; }
    const size_t kstep = (size_t)(BK * 2);
    const size_t hsA = (size_t)HALF * g.lda * 2, hsB = (size_t)HALF * g.ldb * 2, tsA = 2 * hsA, tsB = 2 * hsB;
    const unsigned ldsw = (unsigned)wid * 1024u;
    const int aoff = lds_byte(wr * 64 + fr, fq * 8), boff = lds_byte(wc * 32 + fr, fq * 8);
#define PG8_SA(b, h) (((b) * 2 + (h)) * HTB)
#define PG8_SB(b, h) ((4 + (b) * 2 + (h)) * HTB)
#define PG8_STAGE(bufoff, gbase, voff) do { _Pragma("unroll") for (int _i = 0; _i < 2; ++_i) \
        __builtin_amdgcn_global_load_lds((const unsigned*)((const char*)(gbase) + (voff)[_i]), (LAS unsigned*)(lds + (bufoff) + ldsw + _i * 8192), 16, 0, 0); } while (0)
#define PG8_LDA(dst, b, h) do { _Pragma("unroll") for (int m = 0; m < 4; ++m) _Pragma("unroll") for (int k = 0; k < 2; ++k) dst[m][k] = *(const LAS bf16x8*)(lds + PG8_SA(b, h) + aoff + m * 2048 + k * 1024); } while (0)
#define PG8_LDB(dst, b, h) do { _Pragma("unroll") for (int n = 0; n < 2; ++n) _Pragma("unroll") for (int k = 0; k < 2; ++k) dst[n][k] = *(const LAS bf16x8*)(lds + PG8_SB(b, h) + boff + n * 2048 + k * 1024); } while (0)
#define PG8_MMA(ai, bj, At, Bt) do { __builtin_amdgcn_s_setprio(1); _Pragma("unroll") for (int m = 0; m < 4; ++m) _Pragma("unroll") for (int n = 0; n < 2; ++n) _Pragma("unroll") for (int k = 0; k < 2; ++k) \
        acc[ai][bj][m][n] = __builtin_amdgcn_mfma_f32_16x16x32_bf16(Bt[n][k], At[m][k], acc[ai][bj][m][n], 0, 0, 0); __builtin_amdgcn_s_setprio(0); } while (0)
#define PG8_WAIT_V(n) asm volatile("s_waitcnt vmcnt(" #n ")" ::: "memory")
#define PG8_WAIT_L(n) asm volatile("s_waitcnt lgkmcnt(" #n ")" ::: "memory")
#define PG8_BAR __builtin_amdgcn_s_barrier()
#define PG8_SCHED __builtin_amdgcn_sched_barrier(0)
    Unit cur, nxt; int ui = 0;
    if (!S.next(0, cur)) return;
    f32x4 acc[2][2][4][2];
#pragma unroll
    for (int a = 0; a < 2; ++a)
#pragma unroll
        for (int b = 0; b < 2; ++b)
#pragma unroll
            for (int m = 0; m < 4; ++m)
#pragma unroll
                for (int n = 0; n < 2; ++n) acc[a][b][m][n] = (f32x4){0.f, 0.f, 0.f, 0.f};
    bf16x8 At[4][2], B0[2][2], B1[2][2];
    const char* cA = (const char*)g.A + (size_t)cur.pm * tsA; const char* cB = (const char*)g.Bt + (size_t)cur.pn * tsB;
    PG8_STAGE(PG8_SB(0, 0), cB, voffB); PG8_STAGE(PG8_SB(0, 1), cB + hsB, voffB); PG8_STAGE(PG8_SA(0, 0), cA, voffA); PG8_STAGE(PG8_SA(0, 1), cA + hsA, voffA);
    if (wr == 1) PG8_BAR;
    PG8_WAIT_V(2); PG8_BAR;
    PG8_STAGE(PG8_SB(1, 0), cB + kstep, voffB); PG8_STAGE(PG8_SA(1, 0), cA + kstep, voffA); PG8_STAGE(PG8_SB(1, 1), cB + hsB + kstep, voffB);
    PG8_WAIT_V(6); PG8_BAR;
    for (;;) {
        const bool has_next = S.next(ui + 1, nxt);
        const char* nA = has_next ? (const char*)g.A + (size_t)nxt.pm * tsA : cA; const char* nB = has_next ? (const char*)g.Bt + (size_t)nxt.pn * tsB : cB;
        for (int t = 0; t < nt; t += 2) {
            const bool last = (t == nt - 2);
            const char* a1 = cA + (size_t)(t + 1) * kstep;
            const char* a2 = last ? nA : cA + (size_t)(t + 2) * kstep; const char* b2 = last ? nB : cB + (size_t)(t + 2) * kstep;
            const char* a3 = a2 + kstep; const char* b3 = b2 + kstep;
            PG8_LDB(B0, 0, 0); PG8_LDB(B1, 0, 1); PG8_SCHED; PG8_LDA(At, 0, 0); PG8_STAGE(PG8_SA(1, 1), a1 + hsA, voffA);
            PG8_WAIT_V(8); PG8_WAIT_L(0); PG8_BAR; PG8_MMA(0, 0, At, B0); PG8_MMA(0, 1, At, B1); PG8_BAR; PG8_SCHED;
            PG8_LDA(At, 0, 1); PG8_STAGE(PG8_SB(0, 0), b2, voffB); PG8_STAGE(PG8_SB(0, 1), b2 + hsB, voffB); PG8_STAGE(PG8_SA(0, 0), a2, voffA);
            PG8_WAIT_V(8); PG8_WAIT_L(0); PG8_BAR; PG8_MMA(1, 0, At, B0); PG8_MMA(1, 1, At, B1); PG8_BAR; PG8_SCHED;
            PG8_LDB(B0, 1, 0); PG8_LDB(B1, 1, 1); PG8_SCHED; PG8_LDA(At, 1, 0); PG8_STAGE(PG8_SA(0, 1), a2 + hsA, voffA);
            PG8_WAIT_V(8); PG8_WAIT_L(0); PG8_BAR; PG8_MMA(0, 0, At, B0); PG8_MMA(0, 1, At, B1); PG8_BAR; PG8_SCHED;
            PG8_LDA(At, 1, 1); PG8_STAGE(PG8_SB(1, 0), b3, voffB); PG8_STAGE(PG8_SB(1, 1), b3 + hsB, voffB); PG8_STAGE(PG8_SA(1, 0), a3, voffA);
            PG8_WAIT_V(8); PG8_WAIT_L(0); PG8_BAR; PG8_MMA(1, 0, At, B0); PG8_MMA(1, 1, At, B1); PG8_BAR; PG8_SCHED;
        }
        if constexpr (ALIGN_EPI) { if (wr == 0) PG8_BAR; }
        E(acc, cur, wr, wc, fr, fq);
        if (!has_next) break;
#pragma unroll
        for (int a = 0; a < 2; ++a)
#pragma unroll
            for (int b = 0; b < 2; ++b)
#pragma unroll
                for (int m = 0; m < 4; ++m)
#pragma unroll
                    for (int n = 0; n < 2; ++n) acc[a][b][m][n] = (f32x4){0.f, 0.f, 0.f, 0.f};
        cur = nxt; cA = nA; cB = nB; ++ui;
        if constexpr (ALIGN_EPI) { if (wr == 1) PG8_BAR; }
    }
    PG8_WAIT_V(0);
    if constexpr (!ALIGN_EPI) { if (wr == 0) PG8_BAR; }
    PG8_BAR;
#undef PG8_SA
#undef PG8_SB
#undef PG8_STAGE
#undef PG8_LDA
#undef PG8_LDB
#undef PG8_MMA
#undef PG8_WAIT_V
#undef PG8_WAIT_L
#undef PG8_BAR
#undef PG8_SCHED
}
}
using pg8::cvt_pk_bf16;

__device__ __forceinline__ float bf2f(unsigned v) { return __uint_as_float(v << 16); }
__device__ __forceinline__ float bflo(unsigned w) { return __uint_as_float(w << 16); }
__device__ __forceinline__ float bfhi(unsigned w) { return __uint_as_float(w & 0xffff0000u); }
__device__ __forceinline__ unsigned short f2bf(float f) { return (unsigned short)(cvt_pk_bf16(f, 0.f) & 0xffffu); }
__device__ __forceinline__ float sigmoidf_(float x) { return 1.0f / (1.0f + __expf(-x)); }
__device__ __forceinline__ float siluf_(float x) { return x * sigmoidf_(x); }
__device__ __forceinline__ float gelu_tanh(float y) { const float z = 0.7978845608028654f * (y + 0.044715f * y * y * y); const float t = 1.0f - 2.0f / (1.0f + __expf(2.0f * z)); return 0.5f * y * (1.0f + t); }
__device__ __forceinline__ float wave_sum(float v) {
#pragma unroll
    for (int o = 1; o < 64; o <<= 1) v += __shfl_xor(v, o);
    return v;
}
#define LDS_WAIT() asm volatile("s_waitcnt lgkmcnt(0)" ::: "memory")

struct EpiSwiglu {
    static constexpr bool PERM = true;
    bf16_t* O; int ldc;
    __device__ __forceinline__ void operator()(const f32x4 (&acc)[2][2][4][2], const pg8::Unit& u, int wr, int wc, int fr, int fq) const {
        const int row0 = u.pm * 256 + wr * 64 + fr, col0 = u.pn * 128 + wc * 32 + 8 * fq;
#pragma unroll
        for (int ai = 0; ai < 2; ++ai)
#pragma unroll
            for (int m = 0; m < 4; ++m) {
                const f32x4 g0 = acc[ai][0][m][0], g1 = acc[ai][0][m][1], u0 = acc[ai][1][m][0], u1 = acc[ai][1][m][1];
                u32x4 w;
                w.x = cvt_pk_bf16(siluf_(g0[0]) * u0[0], siluf_(g0[1]) * u0[1]); w.y = cvt_pk_bf16(siluf_(g0[2]) * u0[2], siluf_(g0[3]) * u0[3]);
                w.z = cvt_pk_bf16(siluf_(g1[0]) * u1[0], siluf_(g1[1]) * u1[1]); w.w = cvt_pk_bf16(siluf_(g1[2]) * u1[2], siluf_(g1[3]) * u1[3]);
                *(u32x4*)(O + (size_t)(row0 + ai * 128 + m * 16) * ldc + col0) = w;
                asm volatile("" ::: "memory");
            }
    }
};
struct EpiYraw {
    static constexpr bool PERM = true;
    bf16_t* O; float* part;
    __device__ __forceinline__ void operator()(const f32x4 (&acc)[2][2][4][2], const pg8::Unit& u, int wr, int wc, int fr, int fq) const {
        const int row0 = u.pm * 256 + wr * 64 + fr, col0 = u.pn * 256 + wc * 32 + 8 * fq;
#pragma unroll
        for (int ai = 0; ai < 2; ++ai)
#pragma unroll
            for (int m = 0; m < 4; ++m) {
                const int row = row0 + ai * 128 + m * 16; float ss = 0.f;
#pragma unroll
                for (int bj = 0; bj < 2; ++bj) { const f32x4 v0 = acc[ai][bj][m][0], v1 = acc[ai][bj][m][1];
                    ss += (v0[0] * v0[0] + v0[1] * v0[1]) + (v0[2] * v0[2] + v0[3] * v0[3]) + (v1[0] * v1[0] + v1[1] * v1[1]) + (v1[2] * v1[2] + v1[3] * v1[3]);
                    u32x4 w; w.x = cvt_pk_bf16(v0[0], v0[1]); w.y = cvt_pk_bf16(v0[2], v0[3]); w.z = cvt_pk_bf16(v1[0], v1[1]); w.w = cvt_pk_bf16(v1[2], v1[3]);
                    *(u32x4*)(O + (size_t)row * DM + col0 + bj * 128) = w; }
                ss += __shfl_xor(ss, 16); ss += __shfl_xor(ss, 32);
                if (fq == 0) part[(size_t)row * 16 + u.pn * 4 + wc] = ss;
                asm volatile("" ::: "memory");
            }
    }
};
struct EpiInproj {
    static constexpr bool PERM = true;
    bf16_t *QKV, *Z, *U; float *BETA, *G; const float *a_log, *dt_bias;
    __device__ __forceinline__ void operator()(const f32x4 (&acc)[2][2][4][2], const pg8::Unit& u, int wr, int wc, int fr, int fq) const {
        const int row0 = u.pm * 256 + wr * 64 + fr;
        if (u.pn == 10) {
            if (wc == 0 && fq == 0) {
                const f32x4 al = *(const f32x4*)a_log, db = *(const f32x4*)dt_bias;
#pragma unroll
                for (int ai = 0; ai < 2; ++ai)
#pragma unroll
                    for (int m = 0; m < 4; ++m) { const int row = row0 + ai * 128 + m * 16; const f32x4 bi = acc[ai][0][m][0], an = acc[ai][0][m][1]; f32x4 bo, go;
#pragma unroll
                        for (int j = 0; j < 4; ++j) { bo[j] = 1.0f / (1.0f + expf(-bi[j])); const float xx = an[j] + db[j]; const float sp = xx > 20.f ? xx : log1pf(expf(xx)); go[j] = -expf(al[j]) * sp; }
                        *(f32x4*)(BETA + (size_t)row * 4) = bo; *(f32x4*)(G + (size_t)row * 4) = go; asm volatile("" ::: "memory"); }
            }
            return;
        }
        bf16_t* base; int ldc, colt;
        if (u.pn < 6) { base = QKV; ldc = 1536; colt = u.pn * 256; } else if (u.pn < 8) { base = Z; ldc = 512; colt = (u.pn - 6) * 256; } else { base = U; ldc = 512; colt = (u.pn - 8) * 256; }
        const int col0 = colt + wc * 32 + 8 * fq;
#pragma unroll
        for (int ai = 0; ai < 2; ++ai)
#pragma unroll
            for (int m = 0; m < 4; ++m)
#pragma unroll
                for (int bj = 0; bj < 2; ++bj) { const f32x4 v0 = acc[ai][bj][m][0], v1 = acc[ai][bj][m][1];
                    u32x4 w; w.x = cvt_pk_bf16(v0[0], v0[1]); w.y = cvt_pk_bf16(v0[2], v0[3]); w.z = cvt_pk_bf16(v1[0], v1[1]); w.w = cvt_pk_bf16(v1[2], v1[3]);
                    *(u32x4*)(base + (size_t)(row0 + ai * 128 + m * 16) * ldc + col0 + bj * 128) = w; asm volatile("" ::: "memory"); }
    }
};
struct EpiGlu {
    static constexpr bool PERM = true;
    const bf16_t* YS; bf16_t* YCAT;
    __device__ __forceinline__ void operator()(const f32x4 (&acc)[2][2][4][2], const pg8::Unit& u, int wr, int wc, int fr, int fq) const {
        const int row0 = u.pm * 256 + wr * 64 + fr, col0 = u.pn * 256 + wc * 32 + 8 * fq;
#pragma unroll
        for (int ai = 0; ai < 2; ++ai)
#pragma unroll
            for (int m = 0; m < 4; ++m)
#pragma unroll
                for (int bj = 0; bj < 2; ++bj) { const int row = row0 + ai * 128 + m * 16, col = col0 + bj * 128;
                    const u32x4 y = *(const u32x4*)(YS + (size_t)row * 512 + col); const f32x4 v0 = acc[ai][bj][m][0], v1 = acc[ai][bj][m][1];
                    u32x4 w; w.x = cvt_pk_bf16(bflo(y.x) * sigmoidf_(v0[0]), bfhi(y.x) * sigmoidf_(v0[1])); w.y = cvt_pk_bf16(bflo(y.y) * sigmoidf_(v0[2]), bfhi(y.y) * sigmoidf_(v0[3]));
                    w.z = cvt_pk_bf16(bflo(y.z) * sigmoidf_(v1[0]), bfhi(y.z) * sigmoidf_(v1[1])); w.w = cvt_pk_bf16(bflo(y.w) * sigmoidf_(v1[2]), bfhi(y.w) * sigmoidf_(v1[3]));
                    *(u32x4*)(YCAT + (size_t)row * DM + 512 + col) = w; asm volatile("" ::: "memory"); }
    }
};

constexpr size_t MiB = 1u << 20;
constexpr size_t W_FF_IN = (size_t)2 * DFF * DM * 2, W_FF_OUT = (size_t)DM * DFF * 2, W_MIX_IN = (size_t)MIXN * DM * 2, W_GLU = 512 * 512 * 2, W_MIX_OUT = (size_t)DM * DM * 2;
constexpr size_t WO_FF1_IN = 0, WO_FF1_OUT = WO_FF1_IN + W_FF_IN, WO_MIX_IN = WO_FF1_OUT + W_FF_OUT, WO_GLU = WO_MIX_IN + W_MIX_IN, WO_MIX_OUT = WO_GLU + W_GLU,
                 WO_FF2_IN = WO_MIX_OUT + W_MIX_OUT, WO_FF2_OUT = WO_FF2_IN + W_FF_IN, W_LAYER = WO_FF2_OUT + W_FF_OUT;
static_assert(W_LAYER * 2 <= 84 * MiB, "weights");
constexpr size_t WS_W = 0, WS_H = 84 * MiB, WS_BIG = 148 * MiB, WS_YR = 324 * MiB, WS_EX = 388 * MiB, WS_SMALL = 500 * MiB, WS_END = 512 * MiB;
constexpr size_t WS_QKV = WS_BIG, WS_Z = WS_BIG + 96 * MiB, WS_U = WS_BIG + 128 * MiB;
constexpr size_t WS_SC = WS_BIG;
constexpr size_t WS_D = WS_EX, WS_RT = WS_YR;
constexpr size_t WS_QP = WS_H, WS_O0T = WS_H + 32 * MiB;
constexpr size_t WS_YS = WS_EX + 64 * MiB;
constexpr size_t WS_YCAT = WS_EX;
constexpr size_t WS_PART = WS_SMALL, WS_MOD = WS_PART + 2 * MiB, WS_BETA = WS_MOD + 1 * MiB, WS_G = WS_BETA + 1 * MiB, WS_EGL = WS_G + 1 * MiB, WS_S5E = WS_EGL + 1 * MiB;
static_assert(WS_S5E + 2 * MiB <= WS_END, "small");
constexpr int LDS_BYTES = 147456;
#ifndef REP_A
#define REP_A 1
#endif
#ifndef REP_B
#define REP_B 1
#endif
#ifndef REP_C
#define REP_C 1
#endif
constexpr size_t WS_CTL = WS_SMALL + 10 * MiB, CTL_BYTES = 16384;

struct Args { const float* in[29]; float* out; unsigned char* ws; int rep_a, rep_b, rep_c, pad; };

__device__ __forceinline__ int src_col(int maptype, int n) {
    if (maptype == 0) return n;
    if (maptype == 1) { const int t = n >> 8, w = n & 255; return (w < 128) ? t * 128 + w : DFF + t * 128 + (w - 128); }
    return n < 2048 ? n : (n < 2560 ? n + 8 : (n < 2568 ? n - 512 : -1));
}
__device__ __forceinline__ void transpose_item(const float* W, int K, int N, bf16_t* WT, LAS float* scr, int kb, int nb, int maptype, int lane) {
    const int k0 = 64 * kb, n0 = 32 * nb; const int sc = src_col(maptype, n0 + (lane & 31));
#pragma unroll 8
    for (int i = 0; i < 32; ++i) { const int kk = 2 * i + (lane >> 5); scr[kk * 33 + (lane & 31)] = sc >= 0 ? W[(size_t)(k0 + kk) * N + sc] : 0.f; }
    LDS_WAIT(); asm volatile("" ::: "memory");
    const int c = lane & 7;
#pragma unroll
    for (int j = 0; j < 4; ++j) { const int n = (lane >> 3) + 8 * j; const LAS float* s = scr + (8 * c) * 33 + n;
        u32x4 o; o.x = cvt_pk_bf16(s[0 * 33], s[1 * 33]); o.y = cvt_pk_bf16(s[2 * 33], s[3 * 33]); o.z = cvt_pk_bf16(s[4 * 33], s[5 * 33]); o.w = cvt_pk_bf16(s[6 * 33], s[7 * 33]);
        *(u32x4*)(WT + (size_t)(n0 + n) * K + k0 + 8 * c) = o; }
    LDS_WAIT(); asm volatile("" ::: "memory");
}

__device__ __forceinline__ void finalize_phase(const float* xsrc, float* xdst, const bf16_t* yraw, const float* part, const float* gate  , float gs, const float* wpost,
                                               const float* wpre, const float* shift, const float* scale, bf16_t* H, int gw, int NGW, int lane) {
    asm volatile("" : "+v"(lane));
    for (int m = gw; m < M; m += NGW) {
        const int b = m / SEQ;
        f32x4 x[4];
#pragma unroll
        for (int j = 0; j < 4; ++j) x[j] = *(const f32x4*)(xsrc + (size_t)m * DM + 4 * lane + 256 * j);
        if (yraw) {
            float ss = 0.f;
#pragma unroll
            for (int q = 0; q < 4; ++q) { const f32x4 p = *(const f32x4*)(part + (size_t)m * 16 + 4 * q); ss += (p[0] + p[1]) + (p[2] + p[3]); }
            const float rstd = rsqrtf(ss * (1.0f / DM) + EPS) * gs;
#pragma unroll
            for (int j = 0; j < 4; ++j) { const int col = 4 * lane + 256 * j; const u32x2 y = *(const u32x2*)(yraw + (size_t)m * DM + col);
                const f32x4 gt = *(const f32x4*)(gate + (size_t)b * NMOD + col), wp = *(const f32x4*)(wpost + col);
                x[j][0] += gt[0] * wp[0] * rstd * bflo(y.x); x[j][1] += gt[1] * wp[1] * rstd * bfhi(y.x); x[j][2] += gt[2] * wp[2] * rstd * bflo(y.y); x[j][3] += gt[3] * wp[3] * rstd * bfhi(y.y);
                *(f32x4*)(xdst + (size_t)m * DM + col) = x[j]; }
        }
        if (H) {
            float s2 = 0.f;
#pragma unroll
            for (int j = 0; j < 4; ++j) s2 += (x[j][0] * x[j][0] + x[j][1] * x[j][1]) + (x[j][2] * x[j][2] + x[j][3] * x[j][3]);
            const float r2 = rsqrtf(wave_sum(s2) * (1.0f / DM) + EPS);
#pragma unroll
            for (int j = 0; j < 4; ++j) { const int col = 4 * lane + 256 * j; const f32x4 wp = *(const f32x4*)(wpre + col), sh = *(const f32x4*)(shift + (size_t)b * NMOD + col), sc = *(const f32x4*)(scale + (size_t)b * NMOD + col);
                u32x2 o; o.x = cvt_pk_bf16(x[j][0] * r2 * wp[0] * (1.f + sc[0]) + sh[0], x[j][1] * r2 * wp[1] * (1.f + sc[1]) + sh[1]);
                o.y = cvt_pk_bf16(x[j][2] * r2 * wp[2] * (1.f + sc[2]) + sh[2], x[j][3] * r2 * wp[3] * (1.f + sc[3]) + sh[3]);
                *(u32x2*)(H + (size_t)m * DM + col) = o; }
        }
    }
}

__device__ __forceinline__ f32x4 mma_nt(lp_t A, int lda_b, lp_t B, int ldb_b, int nkt, int fr, int fq, f32x4 acc) {
    for (int kt = 0; kt < nkt; ++kt) {
        const bf16x8 a = *(const LAS bf16x8*)(A + fr * lda_b + (kt * 32 + fq * 8) * 2);
        const bf16x8 b = *(const LAS bf16x8*)(B + fr * ldb_b + (kt * 32 + fq * 8) * 2);
        acc = __builtin_amdgcn_mfma_f32_16x16x32_bf16(a, b, acc, 0, 0, 0);
    }
    return acc;
}

constexpr int GP_KN = 0, GP_QS = 17408, GP_V = 34816, GP_KST = 51200, GP_ATT = 67584, GP_A = 76800, GP_TT = 93184, GP_GC = 130048, GP_BETA = 130304, GP_BG = 130560, GP_END = 130816;
constexpr int LD136 = 272, LD72 = 144, LDV = 256, LDKS = 128;
__device__ __forceinline__ void gdn_pre_unit(lp_t lds, int u, const bf16_t* QKV, const float* convw, const float* BETA, const float* G,
                                             bf16_t* Dg, bf16_t* RTg, bf16_t* QPg, bf16_t* O0Tg, float* EGL) {
    int tid_ = threadIdx.x; asm volatile("" : "+v"(tid_));
    const int tid = tid_, wid = __builtin_amdgcn_readfirstlane(tid >> 6), lane = tid & 63, fr = lane & 15, fq = lane >> 4;
    const int b = u >> 9, h = (u >> 7) & 3, c = u & 127;
    const size_t row0 = (size_t)b * SEQ + (size_t)c * CH;
    LAS float* sGC = (LAS float*)(lds + GP_GC); LAS float* sBE = (LAS float*)(lds + GP_BETA);
    if (wid == 0) {
        float v = G[(row0 + lane) * 4 + h];
#ifdef DBG_CONST_GB
        v = -0.01f;
#endif
#pragma unroll
        for (int o = 1; o < 64; o <<= 1) { const float t = __shfl_up(v, o); if (lane >= o) v += t; }
        float be = BETA[(row0 + lane) * 4 + h];
#ifdef DBG_CONST_GB
        be = 0.5f;
#endif
        sGC[lane] = v; sBE[lane] = be; *(LAS float*)(lds + GP_BG + lane * 4) = be * expf(v);
    }
    __syncthreads();
    const float gl = sGC[63];
    {
        const int i = tid >> 3, d0 = (tid & 7) * 16; const float gci = sGC[i];
        u32x4 xq[3][4][2];
#pragma unroll
        for (int part = 0; part < 3; ++part)
#pragma unroll
            for (int j = 0; j < 4; ++j) {
                const int t = c * CH + i - 3 + j; const int tc = t >= 0 ? t : 0;
                const bf16_t* src = QKV + ((size_t)b * SEQ + tc) * 1536 + part * 512 + h * 128 + d0;
                u32x4 x0 = *(const u32x4*)src, x1 = *(const u32x4*)(src + 8);
                if (t < 0) { x0 = (u32x4){0u, 0u, 0u, 0u}; x1 = x0; }
                xq[part][j][0] = x0; xq[part][j][1] = x1;
            }
#pragma unroll
        for (int part = 0; part < 3; ++part) {
            const int ch0 = part * 512 + h * 128 + d0;
            float a[16];
#pragma unroll
            for (int e = 0; e < 16; ++e) a[e] = 0.f;
#pragma unroll
            for (int j = 0; j < 4; ++j) {
                const float* wj = convw + j * 1536 + ch0; const u32x4 x0 = xq[part][j][0], x1 = xq[part][j][1];
                const f32x4 w0 = *(const f32x4*)wj, w1 = *(const f32x4*)(wj + 4), w2 = *(const f32x4*)(wj + 8), w3 = *(const f32x4*)(wj + 12);
                a[0] += w0[0] * bflo(x0.x); a[1] += w0[1] * bfhi(x0.x); a[2] += w0[2] * bflo(x0.y); a[3] += w0[3] * bfhi(x0.y);
                a[4] += w1[0] * bflo(x0.z); a[5] += w1[1] * bfhi(x0.z); a[6] += w1[2] * bflo(x0.w); a[7] += w1[3] * bfhi(x0.w);
                a[8] += w2[0] * bflo(x1.x); a[9] += w2[1] * bfhi(x1.x); a[10] += w2[2] * bflo(x1.y); a[11] += w2[3] * bfhi(x1.y);
                a[12] += w3[0] * bflo(x1.z); a[13] += w3[1] * bfhi(x1.z); a[14] += w3[2] * bflo(x1.w); a[15] += w3[3] * bfhi(x1.w);
            }
            float ss = 0.f;
#pragma unroll
            for (int e = 0; e < 16; ++e) { a[e] = a[e] / (1.0f + __expf(-a[e])); ss += a[e] * a[e]; }
            ss += __shfl_xor(ss, 1); ss += __shfl_xor(ss, 2); ss += __shfl_xor(ss, 4);
            float sc = 1.f;
            if (part == 0) sc = rsqrtf(ss + EPS) * 0.08838834764831845f; else if (part == 1) sc = rsqrtf(ss + EPS);
            const lp_t dst = lds + (part == 0 ? GP_QS : (part == 1 ? GP_KN : GP_V)) + i * (part == 2 ? LDV : LD136) + d0 * 2;
            u32x4 o0, o1;
            o0.x = cvt_pk_bf16(a[0] * sc, a[1] * sc); o0.y = cvt_pk_bf16(a[2] * sc, a[3] * sc); o0.z = cvt_pk_bf16(a[4] * sc, a[5] * sc); o0.w = cvt_pk_bf16(a[6] * sc, a[7] * sc);
            o1.x = cvt_pk_bf16(a[8] * sc, a[9] * sc); o1.y = cvt_pk_bf16(a[10] * sc, a[11] * sc); o1.z = cvt_pk_bf16(a[12] * sc, a[13] * sc); o1.w = cvt_pk_bf16(a[14] * sc, a[15] * sc);
            *(LAS u32x4*)dst = o0; *(LAS u32x4*)(dst + 16) = o1;
            if (part == 1) { const float ks = sc * expf(gl - gci);
#pragma unroll
                for (int e = 0; e < 16; ++e) *(LAS unsigned short*)(lds + GP_KST + (d0 + e) * LDKS + i * 2) = f2bf(a[e] * ks); }
        }
    }
    __syncthreads();
    {
#pragma unroll 1
        for (int q = 0; q < 4; ++q) {
            const int idx = wid * 4 + q, isq = idx >> 4, mt = (idx >> 2) & 3, nt = idx & 3;
            f32x4 acc = (f32x4){0.f, 0.f, 0.f, 0.f};
            acc = mma_nt(lds + (isq ? GP_QS : GP_KN) + mt * 16 * LD136, LD136, lds + GP_KN + nt * 16 * LD136, LD136, 4, fr, fq, acc);
            const int jc = nt * 16 + fr; const float gcj = sGC[jc];
#pragma unroll
            for (int jj = 0; jj < 4; ++jj) { const int i = mt * 16 + 4 * fq + jj; const float dec = expf(fminf(sGC[i] - gcj, 0.f));
                if (isq) *(LAS unsigned short*)(lds + GP_ATT + i * LD72 + jc * 2) = f2bf(i >= jc ? acc[jj] * dec : 0.f);
                else *(LAS float*)(lds + GP_A + (i * 64 + jc) * 4) = (i > jc) ? sBE[i] * acc[jj] * dec : 0.f; }
        }
    }
    __syncthreads();
    if (wid < 4) {
        const int col = wid * 64 + lane;
        unsigned lbA = (unsigned)(size_t)(lds + GP_A), lbS = (unsigned)(size_t)(lds + (wid < 2 ? GP_BETA : GP_BG));
        asm volatile("" : "+v"(lbA), "+v"(lbS));
        const lp_t pA = (lp_t)lbA, pS = (lp_t)lbS;
        const lp_t pR = (wid < 2) ? (lds + GP_V + col * 2) : (lds + GP_KN + (col - 128) * 2);
        float T[64];
#pragma unroll
        for (int i = 0; i < 64; ++i) {
            float acc = *(const LAS float*)(pS + i * 4) * bf2f(*(const LAS unsigned short*)(pR + i * (wid < 2 ? LDV : LD136)));
#pragma unroll
#ifdef DBG_NOSOLVE
            for (int j4 = 0; j4 < 0; ++j4) { const f32x4 a = *(const LAS f32x4*)(pA + (i * 64 + j4 * 4) * 4);
#else
            for (int j4 = 0; j4 < (i + 3) / 4; ++j4) { const f32x4 a = *(const LAS f32x4*)(pA + (i * 64 + j4 * 4) * 4);
#endif
                acc = __builtin_fmaf(-a[0], T[j4 * 4], acc);
                if (j4 * 4 + 1 < i) acc = __builtin_fmaf(-a[1], T[j4 * 4 + 1], acc);
                if (j4 * 4 + 2 < i) acc = __builtin_fmaf(-a[2], T[j4 * 4 + 2], acc);
                if (j4 * 4 + 3 < i) acc = __builtin_fmaf(-a[3], T[j4 * 4 + 3], acc); }
            T[i] = acc;
            asm volatile("" ::: "memory");
        }
        const lp_t pT = lds + GP_TT + col * LD72;
#pragma unroll
        for (int q = 0; q < 8; ++q) { u32x4 o; o.x = cvt_pk_bf16(T[8 * q], T[8 * q + 1]); o.y = cvt_pk_bf16(T[8 * q + 2], T[8 * q + 3]); o.z = cvt_pk_bf16(T[8 * q + 4], T[8 * q + 5]); o.w = cvt_pk_bf16(T[8 * q + 6], T[8 * q + 7]);
            *(LAS u32x4*)(pT + q * 16) = o; }
    }
    __syncthreads();
    {
        bf16_t* Du = Dg + (size_t)u * 16384; bf16_t* RTu = RTg + (size_t)u * 16384; bf16_t* QPu = QPg + (size_t)u * 8192; bf16_t* O0u = O0Tg + (size_t)u * 8192;
#pragma unroll 1
        for (int q = 0; q < 24; ++q) {
            const int idx = wid * 24 + q;
            f32x4 acc = (f32x4){0.f, 0.f, 0.f, 0.f};
            if (idx < 32) {
                const int dt = idx >> 2, it = idx & 3;
                acc = mma_nt(lds + GP_TT + (128 + dt * 16) * LD72, LD72, lds + GP_ATT + it * 16 * LD72, LD72, 2, fr, fq, acc);
                const int i = it * 16 + fr, d = dt * 16 + 4 * fq; const float eg = expf(sGC[i]);
                const u32x2 qv = *(const LAS u32x2*)(lds + GP_QS + i * LD136 + d * 2);
                u32x2 o; o.x = cvt_pk_bf16(bflo(qv.x) * eg - acc[0], bfhi(qv.x) * eg - acc[1]); o.y = cvt_pk_bf16(bflo(qv.y) * eg - acc[2], bfhi(qv.y) * eg - acc[3]);
                *(u32x2*)(QPu + i * 128 + d) = o;
            } else if (idx < 64) {
                const int it = (idx - 32) >> 3, nt = (idx - 32) & 7;
                acc = mma_nt(lds + GP_ATT + it * 16 * LD72, LD72, lds + GP_TT + nt * 16 * LD72, LD72, 2, fr, fq, acc);
                const int n = nt * 16 + fr, i = it * 16 + 4 * fq;
#ifdef DBG_O0PATTERN
                acc[0] = 0.01f * (float)((n + i) & 31); acc[1] = -acc[0]; acc[2] = 0.5f * acc[0]; acc[3] = 0.25f;
#endif
                u32x2 o; o.x = cvt_pk_bf16(acc[0], acc[1]); o.y = cvt_pk_bf16(acc[2], acc[3]);
                *(u32x2*)(O0u + n * 64 + i) = o;
            } else if (idx < 128) {
                const int kt = (idx - 64) >> 3, mt = (idx - 64) & 7;
                acc = mma_nt(lds + GP_TT + (128 + kt * 16) * LD72, LD72, lds + GP_KST + mt * 16 * LDKS, LDKS, 2, fr, fq, acc);
                const int m = mt * 16 + fr, k = kt * 16 + 4 * fq;
                u32x2 o; o.x = cvt_pk_bf16(acc[0], acc[1]); o.y = cvt_pk_bf16(acc[2], acc[3]);
                *(u32x2*)(Du + m * 128 + k) = o;
            } else {
                const int mt = (idx - 128) >> 3, nt = (idx - 128) & 7;
                acc = mma_nt(lds + GP_KST + mt * 16 * LDKS, LDKS, lds + GP_TT + nt * 16 * LD72, LD72, 2, fr, fq, acc);
                const int n = nt * 16 + fr, m = mt * 16 + 4 * fq;
                u32x2 o; o.x = cvt_pk_bf16(acc[0], acc[1]); o.y = cvt_pk_bf16(acc[2], acc[3]);
                *(u32x2*)(RTu + n * 128 + m) = o;
            }
        }
        if (tid == 0) EGL[u] = expf(gl);
    }
    __syncthreads();
}

constexpr int SCAN_WGS = 128, SCAN_IMG = 16 * 272;
struct ScanSet { bf16x8 d[4]; u32x2 r; float egl; };
__device__ __forceinline__ void scan_load(ScanSet& R, const bf16_t* Dg, const bf16_t* RTg, const float* EGL, int u, unsigned offD, unsigned offR) {
    const bf16_t* Du = Dg + (size_t)u * 16384; const bf16_t* RTu = RTg + (size_t)u * 16384;
#pragma unroll
    for (int kt = 0; kt < 4; ++kt) R.d[kt] = *(const bf16x8*)(Du + offD + kt * 32);
    R.r = *(const u32x2*)(RTu + offR);
    R.egl = EGL[u];
}
__device__ __forceinline__ void scan_step(lp_t lds, int cur, const ScanSet& R, f32x4& a, bf16_t* SCg, int u, int wid, unsigned offS, int fr, int fq) {
    const lp_t img = lds + cur * SCAN_IMG + fr * LD136 + fq * 16, nimg = lds + (cur ^ 1) * SCAN_IMG + fr * LD136 + (16 * wid + 4 * fq) * 2;
    bf16x8 b[4];
#pragma unroll
    for (int kt = 0; kt < 4; ++kt) b[kt] = *(const LAS bf16x8*)(img + kt * 64);
    if (wid < 4) *(bf16x8*)(SCg + (size_t)u * 16384 + offS) = (wid == 0) ? b[0] : ((wid == 1) ? b[1] : ((wid == 2) ? b[2] : b[3]));
    f32x4 t = (f32x4){0.f, 0.f, 0.f, 0.f};
#pragma unroll
    for (int kt = 0; kt < 4; ++kt) t = __builtin_amdgcn_mfma_f32_16x16x32_bf16(R.d[kt], b[kt], t, 0, 0, 0);
    const u32x2 r = R.r;
    a[0] = R.egl * a[0] + bflo(r.x) - t[0]; a[1] = R.egl * a[1] + bfhi(r.x) - t[1];
    a[2] = R.egl * a[2] + bflo(r.y) - t[2]; a[3] = R.egl * a[3] + bfhi(r.y) - t[3];
    u32x2 o; o.x = cvt_pk_bf16(a[0], a[1]); o.y = cvt_pk_bf16(a[2], a[3]);
    *(LAS u32x2*)nimg = o;
}
__device__ __forceinline__ void gdn_scan(lp_t lds, int sx, const bf16_t* Dg, const bf16_t* RTg, const float* EGL, bf16_t* SCg) {
    int tid_ = threadIdx.x; asm volatile("" : "+v"(tid_));
    const int tid = tid_, wid = __builtin_amdgcn_readfirstlane(tid >> 6), lane = tid & 63, fr = lane & 15, fq = lane >> 4;
    const int kx = sx >> 3, bh = (sx & 7) + 8 * (kx >> 3), nb = (kx & 7) * 16, u0 = bh * NCH;
    unsigned offD = (unsigned)((16 * wid + fr) * 128 + 8 * fq), offR = (unsigned)((nb + fr) * 128 + 16 * wid + 4 * fq), offS = (unsigned)((nb + fr) * 128 + 32 * (wid & 3) + 8 * fq);
    asm volatile("" : "+v"(offD), "+v"(offR), "+v"(offS));
    for (int i = tid; i < 2 * SCAN_IMG / 4; i += 512) ((LAS unsigned*)lds)[i] = 0u;
    f32x4 acc = (f32x4){0.f, 0.f, 0.f, 0.f};
    ScanSet R0, R1, R2, R3;
    scan_load(R0, Dg, RTg, EGL, u0, offD, offR); scan_load(R1, Dg, RTg, EGL, u0 + 1, offD, offR); scan_load(R2, Dg, RTg, EGL, u0 + 2, offD, offR);
    __syncthreads();
#define SCAN_CL(x) ((x) < NCH ? (x) : NCH - 1)
#pragma unroll 1
    for (int c = 0; c < NCH; c += 4) {
        scan_load(R3, Dg, RTg, EGL, u0 + SCAN_CL(c + 3), offD, offR); scan_step(lds, 0, R0, acc, SCg, u0 + c, wid, offS, fr, fq); __syncthreads();
        scan_load(R0, Dg, RTg, EGL, u0 + SCAN_CL(c + 4), offD, offR); scan_step(lds, 1, R1, acc, SCg, u0 + c + 1, wid, offS, fr, fq); __syncthreads();
        scan_load(R1, Dg, RTg, EGL, u0 + SCAN_CL(c + 5), offD, offR); scan_step(lds, 0, R2, acc, SCg, u0 + c + 2, wid, offS, fr, fq); __syncthreads();
        scan_load(R2, Dg, RTg, EGL, u0 + SCAN_CL(c + 6), offD, offR); scan_step(lds, 1, R3, acc, SCg, u0 + c + 3, wid, offS, fr, fq); __syncthreads();
    }
#undef SCAN_CL
}

__device__ __forceinline__ void gdn_out_pair(int pairidx, const bf16_t* QPg, const bf16_t* O0Tg, const bf16_t* SCg, const bf16_t* Z, const float* gnw, bf16_t* YCAT) {
    int tid_ = threadIdx.x; asm volatile("" : "+v"(tid_));
    const int tid = tid_, wid = __builtin_amdgcn_readfirstlane(tid >> 6), lane = tid & 63, fr = lane & 15, fq = lane >> 4;
    const int u = pairidx * 2 + (wid >> 2), mt = wid & 3;
    const int b = u >> 9, h = (u >> 7) & 3, c = u & 127;
    const bf16_t* QPu = QPg + (size_t)u * 8192; const bf16_t* O0u = O0Tg + (size_t)u * 8192; const bf16_t* SCu = SCg + (size_t)u * 16384;
    bf16x8 a[4];
#pragma unroll
    for (int kt = 0; kt < 4; ++kt) a[kt] = *(const bf16x8*)(QPu + (16 * mt + fr) * 128 + 32 * kt + 8 * fq);
    f32x4 acc[8]; float ss[4] = {0.f, 0.f, 0.f, 0.f};
#pragma unroll
    for (int nt = 0; nt < 8; ++nt) {
        const u32x2 o0 = *(const u32x2*)(O0u + (16 * nt + fr) * 64 + 16 * mt + 4 * fq);
        acc[nt] = (f32x4){bflo(o0.x), bfhi(o0.x), bflo(o0.y), bfhi(o0.y)};
#ifndef DBG_NO_STATE
#pragma unroll
        for (int kt = 0; kt < 4; ++kt) { const bf16x8 bb = *(const bf16x8*)(SCu + (16 * nt + fr) * 128 + 32 * kt + 8 * fq); acc[nt] = __builtin_amdgcn_mfma_f32_16x16x32_bf16(a[kt], bb, acc[nt], 0, 0, 0); }
#endif
#pragma unroll
        for (int j = 0; j < 4; ++j) ss[j] += acc[nt][j] * acc[nt][j];
    }
#pragma unroll
    for (int j = 0; j < 4; ++j) { float s = ss[j]; s += __shfl_xor(s, 1); s += __shfl_xor(s, 2); s += __shfl_xor(s, 4); s += __shfl_xor(s, 8); ss[j] = rsqrtf(s * (1.0f / HD) + EPS); }
    const size_t row0 = (size_t)b * SEQ + (size_t)c * CH + 16 * mt + 4 * fq;
#pragma unroll
    for (int nt = 0; nt < 8; ++nt) { const int n = 16 * nt + fr; const float w = gnw[n];
#pragma unroll
        for (int j = 0; j < 4; ++j) { const float z = bf2f(Z[(row0 + j) * 512 + h * 128 + n]); float ov = acc[nt][j] * ss[j] * w * siluf_(z);
#ifdef DBG_GDN_ZERO
            ov = 0.f;
#endif
#ifdef DBG_ZONLY
            ov = siluf_(z) * w;
#endif
#ifdef DBG_O0ONLY
            ov = acc[nt][j];
#endif
#ifdef DBG_SANITIZE
            if (!(fabsf(ov) < 1e30f)) ov = 0.f;
#endif
            YCAT[(row0 + j) * DM + h * 128 + n] = f2bf(ov); } }
}

typedef short bf16x4 __attribute__((ext_vector_type(4)));
struct S5W { float are, aim; bf16x4 bre[4], bim[4]; };
__device__ __forceinline__ void s5_abar(int g, int p, const float* a_re, const float* a_im, const float* log_dt, float& are, float& aim, float& f_r, float& f_i) {
    const float ar = fminf(a_re[g * 64 + p], -1e-4f), ai = a_im[g * 64 + p], dt = expf(log_dt[g]);
    const float mag = expf(dt * ar); are = mag * cosf(dt * ai); aim = mag * sinf(dt * ai);
    const float den = ar * ar + ai * ai, zr = are - 1.0f, zi = aim; f_r = (zr * ar + zi * ai) / den; f_i = (zi * ar - zr * ai) / den;
}
__device__ __forceinline__ void s5_setup(S5W& W, int g, int lane, const float* a_re, const float* a_im, const float* log_dt, const float* b_re, const float* b_im) {
    float t0, t1; s5_abar(g, lane, a_re, a_im, log_dt, W.are, W.aim, t0, t1);
    const int fr = lane & 15, fq = lane >> 4;
#pragma unroll
    for (int nt = 0; nt < 4; ++nt) { float a_, b_, f_r, f_i; const int p = 16 * nt + fr; s5_abar(g, p, a_re, a_im, log_dt, a_, b_, f_r, f_i);
        const f32x4 br = *(const f32x4*)(b_re + (size_t)(g * 64 + p) * 16 + 4 * fq), bi = *(const f32x4*)(b_im + (size_t)(g * 64 + p) * 16 + 4 * fq);
        u32x2 w; w.x = cvt_pk_bf16(f_r * br[0] - f_i * bi[0], f_r * br[1] - f_i * bi[1]); w.y = cvt_pk_bf16(f_r * br[2] - f_i * bi[2], f_r * br[3] - f_i * bi[3]); W.bre[nt] = __builtin_bit_cast(bf16x4, w);
        w.x = cvt_pk_bf16(f_r * bi[0] + f_i * br[0], f_r * bi[1] + f_i * br[1]); w.y = cvt_pk_bf16(f_r * bi[2] + f_i * br[2], f_r * bi[3] + f_i * br[3]); W.bim[nt] = __builtin_bit_cast(bf16x4, w); }
}
constexpr int S5_BUT = 0, S5_LDB = 80, S5_XT = 10240, S5_WLDS = 14592;
__device__ __forceinline__ void s5_bu_tile(lp_t wlds, const S5W& W, const u32x2 av, int fr, int fq) {
    const bf16x4 a = __builtin_bit_cast(bf16x4, av);
#pragma unroll
    for (int nt = 0; nt < 4; ++nt) {
        f32x4 c = __builtin_amdgcn_mfma_f32_16x16x16bf16_1k(a, W.bre[nt], (f32x4){0.f, 0.f, 0.f, 0.f}, 0, 0, 0);
        *(LAS f32x4*)(wlds + S5_BUT + (16 * nt + fr) * S5_LDB + fq * 16) = c;
        c = __builtin_amdgcn_mfma_f32_16x16x16bf16_1k(a, W.bim[nt], (f32x4){0.f, 0.f, 0.f, 0.f}, 0, 0, 0);
        *(LAS f32x4*)(wlds + S5_BUT + (64 + 16 * nt + fr) * S5_LDB + fq * 16) = c;
    }
}
__device__ __forceinline__ void s5_pass_a(lp_t wlds, int v, const bf16_t* U, float* E, const float* a_re, const float* a_im, const float* log_dt, const float* b_re, const float* b_im, int lane) {
    asm volatile("" : "+v"(lane));
    const int seg = v & (NSEG - 1), g = (v >> 5) & 31, b = v >> 10, fr = lane & 15, fq = lane >> 4;
    S5W W; s5_setup(W, g, lane, a_re, a_im, log_dt, b_re, b_im);
    float xr = 0.f, xi = 0.f;
    const size_t row0 = (size_t)b * SEQ + (size_t)seg * LSEG;
    u32x2 avn = *(const u32x2*)(U + (row0 + fr) * 512 + g * 16 + 4 * fq);
#pragma unroll 1
    for (int tile = 0; tile < LSEG / 16; ++tile) {
        const u32x2 av = avn; { const size_t rn = row0 + (tile + 1 < LSEG / 16 ? tile + 1 : tile) * 16; avn = *(const u32x2*)(U + (rn + fr) * 512 + g * 16 + 4 * fq); }
        s5_bu_tile(wlds, W, av, fr, fq);
        LDS_WAIT(); asm volatile("" ::: "memory");
        f32x4 re[4], im[4];
#pragma unroll
        for (int q = 0; q < 4; ++q) { re[q] = *(const LAS f32x4*)(wlds + S5_BUT + lane * S5_LDB + q * 16); im[q] = *(const LAS f32x4*)(wlds + S5_BUT + (64 + lane) * S5_LDB + q * 16); }
#pragma unroll
        for (int tt = 0; tt < 16; ++tt) { const float nr = W.are * xr - W.aim * xi + re[tt >> 2][tt & 3], ni = W.are * xi + W.aim * xr + im[tt >> 2][tt & 3]; xr = nr; xi = ni; }
        LDS_WAIT(); asm volatile("" ::: "memory");
    }
    *(f32x2*)(E + ((size_t)v * 64 + lane) * 2) = (f32x2){xr, xi};
}
__device__ __forceinline__ void s5_pass_b(lp_t wlds, int v, const bf16_t* U, const float* E, const float* a_re, const float* a_im, const float* log_dt, const float* b_re, const float* b_im,
                                          const float* c_re, const float* c_im, const float* dvec, bf16_t* YS, int lane) {
    asm volatile("" : "+v"(lane));
    const int seg = v & (NSEG - 1), g = (v >> 5) & 31, b = v >> 10, fr = lane & 15, fq = lane >> 4;
    S5W W; s5_setup(W, g, lane, a_re, a_im, log_dt, b_re, b_im);
    float pr = W.are, pi = W.aim;
#pragma unroll
    for (int s = 0; s < 8; ++s) { const float nr = pr * pr - pi * pi, ni = 2.0f * pr * pi; pr = nr; pi = ni; }
    float xr = 0.f, xi = 0.f;
#pragma unroll 1
    for (int s0 = 0; s0 < seg; s0 += 8) {
        f32x2 e[8];
#pragma unroll
        for (int k = 0; k < 8; ++k) { const int sk = (s0 + k < seg) ? s0 + k : seg - 1; e[k] = *(const f32x2*)(E + ((size_t)(v - seg + sk) * 64 + lane) * 2); }
#pragma unroll
        for (int k = 0; k < 8; ++k) if (s0 + k < seg) { const float nr = pr * xr - pi * xi + e[k][0], ni = pr * xi + pi * xr + e[k][1]; xr = nr; xi = ni; }
    }
    bf16x8 cb[4];
#pragma unroll
    for (int kt = 0; kt < 4; ++kt) { const float* src = (kt < 2 ? c_re : c_im) + (size_t)(g * 16 + fr) * 64 + 32 * (kt & 1) + 8 * fq; const float sg = kt < 2 ? 1.f : -1.f;
        const f32x4 v0 = *(const f32x4*)src, v1 = *(const f32x4*)(src + 4); u32x4 w; w.x = cvt_pk_bf16(sg * v0[0], sg * v0[1]); w.y = cvt_pk_bf16(sg * v0[2], sg * v0[3]); w.z = cvt_pk_bf16(sg * v1[0], sg * v1[1]); w.w = cvt_pk_bf16(sg * v1[2], sg * v1[3]);
        cb[kt] = __builtin_bit_cast(bf16x8, w); }
    const float dco = dvec[g * 16 + fr];
    const lp_t xt = wlds + S5_XT;
    const size_t row0 = (size_t)b * SEQ + (size_t)seg * LSEG;
    u32x2 avn = *(const u32x2*)(U + (row0 + fr) * 512 + g * 16 + 4 * fq); unsigned short uvn[4];
#pragma unroll
    for (int j = 0; j < 4; ++j) uvn[j] = U[(row0 + 4 * fq + j) * 512 + g * 16 + fr];
#pragma unroll 1
    for (int tile = 0; tile < LSEG / 16; ++tile) {
        const size_t r0 = row0 + tile * 16;
        const u32x2 av = avn; float uv[4];
#pragma unroll
        for (int j = 0; j < 4; ++j) uv[j] = bf2f(uvn[j]);
        { const size_t rn = row0 + (tile + 1 < LSEG / 16 ? tile + 1 : tile) * 16; avn = *(const u32x2*)(U + (rn + fr) * 512 + g * 16 + 4 * fq);
#pragma unroll
          for (int j = 0; j < 4; ++j) uvn[j] = U[(rn + 4 * fq + j) * 512 + g * 16 + fr]; }
        s5_bu_tile(wlds, W, av, fr, fq);
        LDS_WAIT(); asm volatile("" ::: "memory");
        f32x4 re[4], im[4];
#pragma unroll
        for (int q = 0; q < 4; ++q) { re[q] = *(const LAS f32x4*)(wlds + S5_BUT + lane * S5_LDB + q * 16); im[q] = *(const LAS f32x4*)(wlds + S5_BUT + (64 + lane) * S5_LDB + q * 16); }
#pragma unroll
        for (int tt = 0; tt < 16; ++tt) { const float nr = W.are * xr - W.aim * xi + re[tt >> 2][tt & 3], ni = W.are * xi + W.aim * xr + im[tt >> 2][tt & 3]; xr = nr; xi = ni;
            *(LAS unsigned short*)(xt + tt * LD136 + lane * 2) = f2bf(xr); *(LAS unsigned short*)(xt + tt * LD136 + (64 + lane) * 2) = f2bf(xi); }
        LDS_WAIT(); asm volatile("" ::: "memory");
        f32x4 acc = (f32x4){0.f, 0.f, 0.f, 0.f};
#pragma unroll
        for (int kt = 0; kt < 4; ++kt) { const bf16x8 a = *(const LAS bf16x8*)(xt + fr * LD136 + (32 * kt + 8 * fq) * 2); acc = __builtin_amdgcn_mfma_f32_16x16x32_bf16(a, cb[kt], acc, 0, 0, 0); }
#pragma unroll
        for (int j = 0; j < 4; ++j) YS[(r0 + 4 * fq + j) * 512 + g * 16 + fr] = f2bf(gelu_tanh(acc[j] + dco * uv[j]));
        LDS_WAIT(); asm volatile("" ::: "memory");
    }
}

#define XB_TMO      128
#define XB_XCNT(j)  (256  + 64 * (j))
#define XB_XSUB(j)  (1280 + 64 * (j))
#define XB_XGEN(j)  (2304 + 64 * (j))
#define XB_TOP      3328
#define XB_TOPGEN   3392
#define XCD_BAR_WORDS 3456
#define XB_SPIN_CAP (1u << 22)
__device__ __forceinline__ unsigned xb_ld(unsigned* p)              { return __hip_atomic_load(p, __ATOMIC_RELAXED, __HIP_MEMORY_SCOPE_AGENT); }
__device__ __forceinline__ unsigned xb_add(unsigned* p, unsigned v) { return __hip_atomic_fetch_add(p, v, __ATOMIC_RELAXED, __HIP_MEMORY_SCOPE_AGENT); }
__device__ __forceinline__ unsigned xb_xcc_id() { return (unsigned)__builtin_amdgcn_s_getreg((3 << 11) | 20) & 0xFu; }
#define XB_SPIN(cond, bar) do { unsigned _sp = 0; while (cond) { __builtin_amdgcn_s_sleep(1); \
    if ((++_sp & 255u) == 0u) { if (xb_ld(&(bar)[XB_TMO])) break; if (_sp > XB_SPIN_CAP) { atomicAdd(&(bar)[XB_TMO], 1u); break; } } } } while (0)
struct XcdBarrier { unsigned* bar; unsigned x; volatile LAS unsigned* st; };
__device__ __forceinline__ XcdBarrier xcd_barrier_post(unsigned* bar, volatile LAS unsigned* st) {
    XcdBarrier b; b.bar = bar; b.x = xb_xcc_id(); b.st = st;
    if (threadIdx.x == 0) (void)xb_add(&bar[XB_XCNT(b.x)], 1u);
    return b;
}
__device__ __forceinline__ void xcd_barrier_complete(unsigned* bar, unsigned x, unsigned& nloc, unsigned& nx) {
    const unsigned G = gridDim.x * gridDim.y * gridDim.z;
    unsigned sum, cnt, mine, sp = 0u;
    for (;;) {
        sum = 0u; cnt = 0u; mine = 0u;
#pragma unroll
        for (unsigned j = 0; j < 16; ++j) { const unsigned c = xb_ld(&bar[XB_XCNT(j)]); sum += c; cnt += (c > 0u) ? 1u : 0u; mine = (j == x) ? c : mine; }
        if (sum == G) break;
        __builtin_amdgcn_s_sleep(1);
        if ((++sp & 255u) == 0u) { if (xb_ld(&bar[XB_TMO])) break; if (sp > XB_SPIN_CAP) { atomicAdd(&bar[XB_TMO], 1u); break; } }
    }
    nloc = mine > 0u ? mine : 1u; nx = cnt > 0u ? cnt : 1u;
}
__device__ __forceinline__ void xcd_barrier(const XcdBarrier& b) {
    asm volatile("s_waitcnt vmcnt(0) lgkmcnt(0)" ::: "memory");
    __syncthreads();
    if (threadIdx.x == 0) {
        unsigned* bar = b.bar;
        __builtin_amdgcn_s_waitcnt(0);
        unsigned nloc = b.st[0], nx = b.st[1];
        if (nloc == 0u) { xcd_barrier_complete(bar, b.x, nloc, nx); b.st[0] = nloc; b.st[1] = nx; }
        const unsigned old = xb_add(&bar[XB_XSUB(b.x)], 1u);
        const unsigned gen = old / nloc;
        if (old + 1u == (gen + 1u) * nloc) {
            __builtin_amdgcn_fence(__ATOMIC_RELEASE, "agent");
            asm volatile("s_waitcnt vmcnt(0)" ::: "memory");
            const unsigned og = xb_add(&bar[XB_TOP], 1u);
            const unsigned tg = og / nx;
            if (og + 1u == (tg + 1u) * nx) xb_add(&bar[XB_TOPGEN], 1u);
            else XB_SPIN(xb_ld(&bar[XB_TOPGEN]) == tg, bar);
            __builtin_amdgcn_fence(__ATOMIC_ACQUIRE, "agent");
            xb_add(&bar[XB_XGEN(b.x)], 1u);
            asm volatile("s_waitcnt vmcnt(0)" ::: "memory");
        } else {
            XB_SPIN(xb_ld(&bar[XB_XGEN(b.x)]) == gen, bar);
            __builtin_amdgcn_fence(__ATOMIC_ACQUIRE, "agent");
            asm volatile("s_waitcnt vmcnt(0)" ::: "memory");
        }
    }
    __syncthreads();
}

__global__ void __launch_bounds__(512, 2) hybrid_fwd(Args args) {
    extern __shared__ __attribute__((aligned(16))) unsigned char lds_raw[];
    cg::grid_group grid = cg::this_grid();
    const lp_t lds = (lp_t)lds_raw;
    const int tid = threadIdx.x, lane = tid & 63, wave = __builtin_amdgcn_readfirstlane(tid >> 6);
    const int G = gridDim.x, bx = blockIdx.x, gw = bx * 8 + wave, NGW = G * 8;
    typedef const __attribute__((address_space(4))) Args* kargp_t;
    const kargp_t kp0 = (kargp_t)__builtin_amdgcn_kernarg_segment_ptr();
#define ARGS() ({ kargp_t p_ = kp0; asm volatile("" : "+s"(p_)); p_; })
    unsigned char* ws = ARGS()->ws;
    float* MOD = (float*)(ws + WS_MOD); float* PART = (float*)(ws + WS_PART);
    bf16_t* H = (bf16_t*)(ws + WS_H); bf16_t* HID = (bf16_t*)(ws + WS_BIG); bf16_t* YR = (bf16_t*)(ws + WS_YR);
    {
        if (tid < 16) ((LAS unsigned*)(lds + LDS_BYTES - 64))[tid] = 0u;
        __syncthreads();
    }
    XcdBarrier xbar = xcd_barrier_post((unsigned*)(ws + WS_CTL), (volatile LAS unsigned*)(lds + LDS_BYTES - 64));
    grid.sync();
#define GSYNC() xcd_barrier(xbar)

    {
        LAS float* scr = (LAS float*)(lds + wave * 8704);
        constexpr int I_FFI = 16 * 176, I_FFO = 44 * 32, I_MXI = 16 * 88, I_GLU = 8 * 16, I_MXO = 16 * 32;
        constexpr int I_LAYER = 2 * I_FFI + 2 * I_FFO + I_MXI + I_GLU + I_MXO;
        for (int it = gw; it < DEPTH * I_LAYER; it += NGW) {
            const int l = it / I_LAYER; int r = it % I_LAYER; bf16_t* wl = (bf16_t*)(ws + WS_W + (size_t)l * W_LAYER);
            if (r < I_FFI) { transpose_item(ARGS()->in[6] + (size_t)l * DM * 2 * DFF, DM, 2 * DFF, (bf16_t*)((char*)wl + WO_FF1_IN), scr, r / 176, r % 176, 1, lane); continue; } r -= I_FFI;
            if (r < I_FFO) { transpose_item(ARGS()->in[7] + (size_t)l * DFF * DM, DFF, DM, (bf16_t*)((char*)wl + WO_FF1_OUT), scr, r / 32, r % 32, 0, lane); continue; } r -= I_FFO;
            if (r < I_MXI) { transpose_item(ARGS()->in[10] + (size_t)l * DM * PROJ_W, DM, PROJ_W, (bf16_t*)((char*)wl + WO_MIX_IN), scr, r / 88, r % 88, 2, lane); continue; } r -= I_MXI;
            if (r < I_GLU) { transpose_item(ARGS()->in[23] + (size_t)l * 512 * 512, 512, 512, (bf16_t*)((char*)wl + WO_GLU), scr, r / 16, r % 16, 0, lane); continue; } r -= I_GLU;
            if (r < I_MXO) { transpose_item(ARGS()->in[24] + (size_t)l * DM * DM, DM, DM, (bf16_t*)((char*)wl + WO_MIX_OUT), scr, r / 32, r % 32, 0, lane); continue; } r -= I_MXO;
            if (r < I_FFI) { transpose_item(ARGS()->in[27] + (size_t)l * DM * 2 * DFF, DM, 2 * DFF, (bf16_t*)((char*)wl + WO_FF2_IN), scr, r / 176, r % 176, 1, lane); continue; } r -= I_FFI;
            transpose_item(ARGS()->in[28] + (size_t)l * DFF * DM, DFF, DM, (bf16_t*)((char*)wl + WO_FF2_OUT), scr, r / 32, r % 32, 0, lane);
        }
        __syncthreads();
        LAS float* ca = (LAS float*)lds; LAS float* red = (LAS float*)(lds + 16384);
        for (int i = tid; i < NB * DM; i += 512) { const float v = ARGS()->in[1][i]; ca[i] = v / (1.0f + expf(-v)); }
        __syncthreads();
        for (int it = bx; it < DEPTH * (NMOD / 64); it += G) {
            const int l = it / (NMOD / 64), cb = it % (NMOD / 64), col = cb * 64 + lane;
            const float* wm = ARGS()->in[2] + (size_t)l * DM * NMOD + col;
            float a0 = 0.f, a1 = 0.f, a2 = 0.f, a3 = 0.f;
#pragma unroll 8
            for (int k = wave * 128; k < wave * 128 + 128; ++k) { const float w = wm[(size_t)k * NMOD]; a0 += ca[k] * w; a1 += ca[DM + k] * w; a2 += ca[2 * DM + k] * w; a3 += ca[3 * DM + k] * w; }
            red[(wave * 4 + 0) * 64 + lane] = a0; red[(wave * 4 + 1) * 64 + lane] = a1; red[(wave * 4 + 2) * 64 + lane] = a2; red[(wave * 4 + 3) * 64 + lane] = a3;
            __syncthreads();
            if (tid < 256) { const int b = tid >> 6; float s = ARGS()->in[3][(size_t)l * NMOD + col];
#pragma unroll
                for (int w = 0; w < 8; ++w) s += red[(w * 4 + b) * 64 + lane];
                MOD[((size_t)l * NB + b) * NMOD + col] = s; }
            __syncthreads();
        }
    }
    GSYNC();
    finalize_phase(ARGS()->in[0], nullptr, nullptr, nullptr, nullptr, 0.f, nullptr, ARGS()->in[4], MOD + 0 * DM, MOD + 1 * DM, H, gw, NGW, lane);
    GSYNC();

#pragma unroll 1
    for (int l = 0; l < DEPTH; ++l) {
        const unsigned char* wl = ws + WS_W + (size_t)l * W_LAYER;
        const float* modl = MOD + (size_t)l * NB * NMOD;
#pragma unroll 1
        for (int sub = 0; sub < 3; ++sub) {
#ifdef SKIP_MIX
            if (sub == 1) continue;
#endif
            if (sub != 1) {
                { pg8::Gemm g{H, (const bf16_t*)(wl + (sub == 0 ? WO_FF1_IN : WO_FF2_IN)), M, 2 * DFF, DM, DM, DM}; pg8::StaticOrder S; S.init(M, 2 * DFF, G, bx);
                  EpiSwiglu E{HID, DFF};
#pragma unroll 1
                  for (int rep = 0; rep < ARGS()->rep_a; ++rep) { pg8::gemm_phase<EpiSwiglu, true>(lds, g, S, E); __syncthreads(); }
 }
                GSYNC();
                { pg8::Gemm g{HID, (const bf16_t*)(wl + (sub == 0 ? WO_FF1_OUT : WO_FF2_OUT)), M, DM, DFF, DFF, DFF}; pg8::StaticOrder S; S.init(M, DM, G, bx);
                  EpiYraw E{YR, PART};
#pragma unroll 1
                  for (int rep = 0; rep < ARGS()->rep_a; ++rep) { pg8::gemm_phase<EpiYraw, true>(lds, g, S, E); __syncthreads(); }
 }
                GSYNC();
            } else {
                bf16_t* QKV = (bf16_t*)(ws + WS_QKV); bf16_t* Zb = (bf16_t*)(ws + WS_Z); bf16_t* Ub = (bf16_t*)(ws + WS_U);
                float* BETA = (float*)(ws + WS_BETA); float* Gg = (float*)(ws + WS_G); float* EGL = (float*)(ws + WS_EGL); float* S5E = (float*)(ws + WS_S5E);
                bf16_t* Dg = (bf16_t*)(ws + WS_D); bf16_t* RTg = (bf16_t*)(ws + WS_RT); bf16_t* QPg = (bf16_t*)(ws + WS_QP); bf16_t* O0Tg = (bf16_t*)(ws + WS_O0T);
                bf16_t* SCg = (bf16_t*)(ws + WS_SC); bf16_t* YS = (bf16_t*)(ws + WS_YS); bf16_t* YCAT = (bf16_t*)(ws + WS_YCAT);
                { pg8::Gemm g{H, (const bf16_t*)(wl + WO_MIX_IN), M, MIXN, DM, DM, DM}; pg8::StaticOrder S; S.init(M, MIXN, G, bx);
                  EpiInproj E{QKV, Zb, Ub, BETA, Gg, ARGS()->in[12] + l * 4, ARGS()->in[13] + l * 4};
#ifndef SKIP_GI1
pg8::gemm_phase<EpiInproj, true>(lds, g, S, E);
#endif
 }
                GSYNC();

#pragma unroll 1
                for (int rep = 0; rep < ARGS()->rep_b; ++rep)
                for (int u = bx; u < NUNIT; u += G) gdn_pre_unit(lds, u, QKV, ARGS()->in[11] + (size_t)l * 4 * 1536, BETA, Gg, Dg, RTg, QPg, O0Tg, EGL);

                __syncthreads();

#ifndef SKIP_S5A
                for (int v = gw; v < NB * S5G * NSEG; v += NGW)
                    s5_pass_a(lds + wave * S5_WLDS, v, Ub, S5E, ARGS()->in[15] + l * 2048, ARGS()->in[16] + l * 2048, ARGS()->in[17] + l * 32, ARGS()->in[18] + (size_t)l * 32768, ARGS()->in[19] + (size_t)l * 32768, lane);
#endif

                GSYNC();

#pragma unroll 1
                for (int rep = 0; rep < ARGS()->rep_c; ++rep) { if (bx < SCAN_WGS) gdn_scan(lds, bx, Dg, RTg, EGL, SCg); __syncthreads(); }
                {


#ifndef SKIP_S5B
                if (bx >= SCAN_WGS) for (int v = (bx - SCAN_WGS) * 8 + wave; v < NB * S5G * NSEG; v += (G - SCAN_WGS) * 8)
                    s5_pass_b(lds + wave * S5_WLDS, v, Ub, S5E, ARGS()->in[15] + l * 2048, ARGS()->in[16] + l * 2048, ARGS()->in[17] + l * 32, ARGS()->in[18] + (size_t)l * 32768, ARGS()->in[19] + (size_t)l * 32768,
                              ARGS()->in[20] + (size_t)l * 32768, ARGS()->in[21] + (size_t)l * 32768, ARGS()->in[22] + l * 512, YS, lane);
#endif
                }

                GSYNC();

#ifndef SKIP_OUT
                for (int p = bx; p < NUNIT / 2; p += G) gdn_out_pair(p, QPg, O0Tg, SCg, Zb, ARGS()->in[14] + l * HD, YCAT);
#endif

                { pg8::Gemm g{YS, (const bf16_t*)(wl + WO_GLU), M, 512, 512, 512, 512}; pg8::StaticOrder S; S.init(M, 512, G, bx);
                  EpiGlu E{YS, YCAT};
#ifndef SKIP_GG1
pg8::gemm_phase<EpiGlu, true>(lds, g, S, E);
#endif
 }
                GSYNC();
                { pg8::Gemm g{YCAT, (const bf16_t*)(wl + WO_MIX_OUT), M, DM, DM, DM, DM}; pg8::StaticOrder S; S.init(M, DM, G, bx);
                  EpiYraw E{YR, PART};
#ifndef SKIP_GY2
pg8::gemm_phase<EpiYraw, true>(lds, g, S, E);
#endif
 }
                GSYNC();
            }
            {
                const float* xsrc = (l == 0 && sub == 0) ? ARGS()->in[0] : ARGS()->out;
                const float* wpost = (sub == 0 ? ARGS()->in[5] : (sub == 1 ? ARGS()->in[9] : ARGS()->in[26])) + l * DM;
                const float* gate = modl + (3 * sub + 2) * DM; const float gs = sub == 1 ? 1.0f : 0.5f;
                const bool last = (l == DEPTH - 1 && sub == 2);
                const int nl = sub == 2 ? l + 1 : l, nsub = sub == 2 ? 0 : sub + 1;
                const float* wpre = last ? nullptr : (nsub == 0 ? ARGS()->in[4] : (nsub == 1 ? ARGS()->in[8] : ARGS()->in[25])) + nl * DM;
                const float* modn = MOD + (size_t)(last ? 0 : nl) * NB * NMOD;
                finalize_phase(xsrc, ARGS()->out, YR, PART, gate, gs, wpost, wpre, modn + (3 * nsub) * DM, modn + (3 * nsub + 1) * DM, last ? nullptr : H, gw, NGW, lane);
            }
            GSYNC();
        }
    }
}

extern "C" void kernel_launch(void* const* d_in, const int* in_sizes, int n_in, void* d_out, int out_size, void* d_ws, size_t ws_size, hipStream_t stream) {
    static int grid = 0;
    if (grid == 0) {
        if (n_in != 29 || ws_size < WS_END) { fprintf(stderr, "kernel_launch: unexpected n_in %d or ws %zu\n", n_in, ws_size); grid = -1; return; }
        int dev = 0, cus = 0, per_cu = 0;
        hipGetDevice(&dev); hipDeviceGetAttribute(&cus, hipDeviceAttributeMultiprocessorCount, dev);
        hipFuncSetAttribute((const void*)hybrid_fwd, hipFuncAttributeMaxDynamicSharedMemorySize, LDS_BYTES);
        hipOccupancyMaxActiveBlocksPerMultiprocessor(&per_cu, (const void*)hybrid_fwd, 512, LDS_BYTES);
        if (per_cu < 1) { fprintf(stderr, "kernel_launch: occupancy query says %d blocks per CU\n", per_cu); per_cu = 1; }
        (void)hipGetLastError();
        grid = cus * 1;
    }
    if (grid < 0) return;
    if (hipMemsetAsync((char*)d_ws + WS_CTL, 0, CTL_BYTES, stream) != hipSuccess) { fprintf(stderr, "memset failed\n"); return; }
    Args a{};
    for (int i = 0; i < 29; ++i) a.in[i] = (const float*)d_in[i];
    a.out = (float*)d_out; a.ws = (unsigned char*)d_ws; a.rep_a = REP_A; a.rep_b = REP_B; a.rep_c = REP_C; a.pad = 0;
    void* kargs[] = {&a};
    hipError_t e = hipLaunchCooperativeKernel((const void*)hybrid_fwd, dim3(grid), dim3(512), kargs, LDS_BYTES, stream);
    if (e != hipSuccess) fprintf(stderr, "cooperative launch failed: %s (grid %d)\n", hipGetErrorString(e), grid);
}
```
